# Optimizing an MI355X kernel written in HIP

```python
import jax, jax.numpy as jnp
from jax import lax
import numpy as np

D_MODEL = 1024
BATCH = 8
SEQ = 4096
DEPTH = 2

ATTN_HEAD_DIM = 64
ATTN_HEADS_PER_GROUP = 4
ATTN_GROUPS = ((128, 1), (512, 4), (2048, 16))
N_ATTN_GROUPS = 3
ATTN_HEADS = ATTN_HEADS_PER_GROUP * N_ATTN_GROUPS
ATTN_WIDTH = ATTN_HEADS * ATTN_HEAD_DIM
ATTN_OUT_WIDTH = ATTN_HEADS_PER_GROUP * ATTN_HEAD_DIM
ATTN_BLOCK = 128

DN_HEADS = 4
DN_HEAD_DIM = 128
DN_WIDTH = DN_HEADS * DN_HEAD_DIM
DN_CONV = 4
DN_CHUNK = 64

D_FF = 2816
FFN_CONV = 3

NORM_EPS = 1e-6

IN_SIZES = (ATTN_WIDTH, ATTN_WIDTH, ATTN_WIDTH,
            3 * DN_WIDTH,
            DN_HEADS, DN_HEADS,
            DN_WIDTH,
            D_MODEL, D_MODEL)
IN_WIDTH = sum(IN_SIZES)

kernel_name = "hybrid_dilated_attn_gated_deltanet_convglu"


def rms_norm(x, w):
    x32 = x.astype(jnp.float32)
    y = x32 * lax.rsqrt(jnp.mean(x32 * x32, axis=-1, keepdims=True) + NORM_EPS)
    return (y * w.astype(jnp.float32)).astype(x.dtype)


def l2_norm(x):
    return x * lax.rsqrt(jnp.sum(x * x, axis=-1, keepdims=True) + NORM_EPS)


def causal_dwconv(x, w):
    K = w.shape[0]
    S = x.shape[1]
    xp = jnp.pad(x, ((0, 0), (K - 1, 0), (0, 0)))
    return sum(xp[:, j:j + S] * w[j] for j in range(K))


def dilated_window_attention(q, k, v, window, dilation):
    B, S, H, Dh = q.shape
    span = window // dilation
    L = S // dilation
    nb = -(-L // ATTN_BLOCK)
    Lp = nb * ATTN_BLOCK
    Bp = B * dilation

    def to_blocks(t):
        t = t.astype(jnp.float32).reshape(B, L, dilation, H, Dh).transpose(0, 2, 1, 3, 4)
        t = t.reshape(Bp, L, H, Dh)
        t = jnp.pad(t, ((0, 0), (0, Lp - L), (0, 0), (0, 0)))
        return t.reshape(Bp, nb, ATTN_BLOCK, H, Dh)

    qb, kb, vb = to_blocks(q), to_blocks(k), to_blocks(v)

    def band_keys(t):
        prev = jnp.pad(t[:, :-1], ((0, 0), (1, 0), (0, 0), (0, 0), (0, 0)))
        return jnp.concatenate([prev, t], axis=2)

    kw, vw = band_keys(kb), band_keys(vb)
    s = jnp.einsum('bnqhd,bnkhd->bnhqk', qb, kw) * (Dh ** -0.5)
    blk = jnp.arange(nb)[:, None] * ATTN_BLOCK
    qpos = blk + jnp.arange(ATTN_BLOCK)[None, :]
    kpos = blk - ATTN_BLOCK + jnp.arange(2 * ATTN_BLOCK)[None, :]
    rel = qpos[:, :, None] - kpos[:, None, :]
    valid = (rel >= 0) & (rel <= span) & (kpos[:, None, :] >= 0)
    s = jnp.where(valid[None, :, None], s, -jnp.inf)
    m = jnp.max(s, axis=-1, keepdims=True)
    p = jnp.exp(s - m)
    den = jnp.sum(p, axis=-1)
    o = jnp.einsum('bnhqk,bnkhd->bnqhd', p, vw) / jnp.swapaxes(den, 2, 3)[..., None]
    lse = jnp.swapaxes(m[..., 0] + jnp.log(den), 2, 3)

    o = o.reshape(Bp, Lp, H, Dh)[:, :L].reshape(B, dilation, L, H, Dh)
    o = o.transpose(0, 2, 1, 3, 4).reshape(B, S, H, Dh)
    lse = lse.reshape(Bp, Lp, H)[:, :L].reshape(B, dilation, L, H)
    lse = lse.transpose(0, 2, 1, 3).reshape(B, S, H)
    return o, lse


def gated_delta_rule_chunked(q, k, v, g, beta):
    B, S, H, dk = q.shape
    dv = v.shape[-1]
    C = DN_CHUNK
    N = S // C

    def chunk(t):
        return t.reshape(B, N, C, H, -1).transpose(0, 3, 1, 2, 4)

    qc, kc, vc = chunk(q), chunk(k), chunk(v)
    gc = jnp.cumsum(g.reshape(B, N, C, H).transpose(0, 3, 1, 2), axis=-1)
    bc = beta.reshape(B, N, C, H).transpose(0, 3, 1, 2)[..., None]
    kb, vb = kc * bc, vc * bc

    incl = jnp.tril(jnp.ones((C, C), dtype=bool))
    strict = jnp.tril(jnp.ones((C, C), dtype=bool), -1)
    decay = jnp.exp(jnp.where(incl, gc[..., :, None] - gc[..., None, :], -jnp.inf))

    M = jnp.where(strict, jnp.einsum('bhncd,bhnjd->bhncj', kb, kc) * decay, 0.0)
    A = jnp.eye(C, dtype=jnp.float32) + M
    rhs = jnp.concatenate([vb, kb * jnp.exp(gc)[..., None]], axis=-1)
    uw = lax.linalg.triangular_solve(A, rhs, left_side=True, lower=True, unit_diagonal=True)
    u, w = uw[..., :dv], uw[..., dv:]

    qk = jnp.einsum('bhncd,bhnjd->bhncj', qc, kc) * decay
    q_dec = qc * jnp.exp(gc)[..., None]
    k_dec = kc * jnp.exp(gc[..., -1:] - gc)[..., None]
    g_last = jnp.exp(gc[..., -1])

    def step(state, inp):
        u_i, w_i, qk_i, qd_i, kd_i, gl_i = inp
        v_new = u_i - jnp.einsum('bhcd,bhde->bhce', w_i, state)
        o_i = (jnp.einsum('bhcd,bhde->bhce', qd_i, state)
               + jnp.einsum('bhcj,bhje->bhce', qk_i, v_new))
        state = state * gl_i[..., None, None] + jnp.einsum('bhcd,bhce->bhde', kd_i, v_new)
        return state, o_i

    xs = tuple(jnp.moveaxis(t, 2, 0) for t in (u, w, qk, q_dec, k_dec, g_last))
    state0 = jnp.zeros((B, H, dk, dv), dtype=jnp.float32)
    _, o = lax.scan(step, state0, xs)
    return o.transpose(1, 0, 3, 2, 4).reshape(B, S, H, dv)


def hybrid_mixer(xn, w_in, dn_conv_w, dn_a_log, dn_dt_bias, dn_onorm_w, w_pa, w_pb, w_o):
    B, S, _ = xn.shape
    proj = xn @ w_in
    split_at = [int(i) for i in np.cumsum(IN_SIZES)[:-1]]
    aq, ak, av, dqkv, dbeta, da, dz, gate_a, gate_b = jnp.split(proj, split_at, axis=-1)

    hs = (B, S, N_ATTN_GROUPS, ATTN_HEADS_PER_GROUP, ATTN_HEAD_DIM)
    aq, ak, av = aq.reshape(hs), ak.reshape(hs), av.reshape(hs)
    outs, lses = [], []
    for gi, (window, dilation) in enumerate(ATTN_GROUPS):
        o_g, lse_g = dilated_window_attention(aq[:, :, gi], ak[:, :, gi], av[:, :, gi], window, dilation)
        outs.append(o_g)
        lses.append(lse_g)
    alpha = jax.nn.softmax(jnp.stack(lses, axis=0), axis=0)
    o_a = jnp.sum(alpha[..., None] * jnp.stack(outs, axis=0), axis=0)
    o_a = o_a.reshape(B, S, ATTN_OUT_WIDTH).astype(xn.dtype)

    dqkv = jax.nn.silu(causal_dwconv(dqkv, dn_conv_w)).astype(jnp.float32)
    dq, dk, dv = jnp.split(dqkv, 3, axis=-1)
    hd = (B, S, DN_HEADS, DN_HEAD_DIM)
    dq = l2_norm(dq.reshape(hd)) * (DN_HEAD_DIM ** -0.5)
    dk = l2_norm(dk.reshape(hd))
    dv = dv.reshape(hd)
    beta = jax.nn.sigmoid(dbeta.astype(jnp.float32))
    g = -jnp.exp(dn_a_log.astype(jnp.float32)) * jax.nn.softplus(
        da.astype(jnp.float32) + dn_dt_bias.astype(jnp.float32))
    o_b = gated_delta_rule_chunked(dq, dk, dv, g, beta)
    o_b = rms_norm(o_b, dn_onorm_w) * jax.nn.silu(dz.astype(jnp.float32).reshape(hd))
    o_b = o_b.reshape(B, S, DN_WIDTH).astype(xn.dtype)

    y = jax.nn.sigmoid(gate_a) * (o_a @ w_pa) + jax.nn.sigmoid(gate_b) * (o_b @ w_pb)
    return y @ w_o


def conv_glu_ffn(xn, w_up, conv_w, conv_b, w_down):
    h = causal_dwconv(xn @ w_up, conv_w) + conv_b
    gate, val = jnp.split(h, 2, axis=-1)
    return (jax.nn.silu(gate) * val) @ w_down


def setup_inputs(seed: int = 0) -> dict:
    key = jax.random.key(seed)
    ks = jax.random.split(key, 20)
    f32 = jnp.float32

    def nrm(k, shape, scale):
        return jax.random.normal(k, shape, f32) * scale

    dt = jnp.exp(jax.random.uniform(ks[5], (DEPTH, DN_HEADS), f32)
                 * (jnp.log(0.1) - jnp.log(0.001)) + jnp.log(0.001))
    return {
        "x": nrm(ks[0], (BATCH, SEQ, D_MODEL), 1.0),
        "norm1_w": 1.0 + nrm(ks[1], (DEPTH, D_MODEL), 0.02),
        "w_in": nrm(ks[2], (DEPTH, D_MODEL, IN_WIDTH), D_MODEL ** -0.5),
        "dn_conv_w": nrm(ks[3], (DEPTH, DN_CONV, 3 * DN_WIDTH), DN_CONV ** -0.5),
        "dn_a_log": jnp.log(jax.random.uniform(ks[4], (DEPTH, DN_HEADS), f32, 1.0, 16.0)),
        "dn_dt_bias": dt + jnp.log(-jnp.expm1(-dt)),
        "dn_onorm_w": 1.0 + nrm(ks[6], (DEPTH, DN_HEAD_DIM), 0.02),
        "w_pa": nrm(ks[7], (DEPTH, ATTN_OUT_WIDTH, D_MODEL), ATTN_OUT_WIDTH ** -0.5),
        "w_pb": nrm(ks[8], (DEPTH, DN_WIDTH, D_MODEL), DN_WIDTH ** -0.5),
        "w_o": nrm(ks[9], (DEPTH, D_MODEL, D_MODEL), D_MODEL ** -0.5),
        "norm2_w": 1.0 + nrm(ks[10], (DEPTH, D_MODEL), 0.02),
        "w_up": nrm(ks[11], (DEPTH, D_MODEL, 2 * D_FF), D_MODEL ** -0.5),
        "ffn_conv_w": nrm(ks[12], (DEPTH, FFN_CONV, 2 * D_FF), FFN_CONV ** -0.5),
        "ffn_conv_b": nrm(ks[13], (DEPTH, 2 * D_FF), 0.01),
        "w_down": nrm(ks[14], (DEPTH, D_FF, D_MODEL), D_FF ** -0.5),
        "final_norm_w": 1.0 + nrm(ks[15], (D_MODEL,), 0.02),
    }


def reference(x, norm1_w, w_in, dn_conv_w, dn_a_log, dn_dt_bias, dn_onorm_w, w_pa, w_pb, w_o,
              norm2_w, w_up, ffn_conv_w, ffn_conv_b, w_down, final_norm_w):
    for l in range(DEPTH):
        h = x + hybrid_mixer(rms_norm(x, norm1_w[l]), w_in[l], dn_conv_w[l], dn_a_log[l],
                             dn_dt_bias[l], dn_onorm_w[l], w_pa[l], w_pb[l], w_o[l])
        x = h + conv_glu_ffn(rms_norm(h, norm2_w[l]), w_up[l], ffn_conv_w[l], ffn_conv_b[l], w_down[l])
    return rms_norm(x, final_norm_w)
```

```cpp
#include <hip/hip_runtime.h>
#include <hip/hip_cooperative_groups.h>
#include <cstdio>
namespace cg = cooperative_groups;

#ifndef MODE_COOP
#define MODE_COOP 1
#endif

#define DI __device__ __forceinline__
typedef unsigned short bf16_t;
typedef short bf16x8 __attribute__((ext_vector_type(8)));
typedef float f32x4 __attribute__((ext_vector_type(4)));
typedef unsigned u32x4 __attribute__((ext_vector_type(4)));
typedef unsigned u32x2 __attribute__((ext_vector_type(2)));

constexpr int T_ = 32768, S_ = 4096, DM = 1024, NIN = 6400, INW = 6408, DFF = 2816, NUP = 5632;
constexpr int NT = 512;
constexpr size_t MiB = (size_t)1 << 20;
constexpr size_t O_W = 0, O_XN = 33 * MiB, O_QKV = 97 * MiB, O_DQKV = 241 * MiB, O_DZ = 337 * MiB, O_SG = 369 * MiB, O_BG = 497 * MiB, O_GL = 498 * MiB, O_BAR = 499 * MiB, O_END = 500 * MiB;
constexpr size_t O_OG = O_XN, O_LSE = O_XN + 48 * MiB, O_Y = O_XN;
constexpr size_t O_OBN_NAIVE = O_QKV;
constexpr size_t O_OA = O_DQKV + 64 * MiB, O_OBN = O_QKV + 80 * MiB;
constexpr size_t O_UPH = O_QKV, O_ACT = O_QKV + 176 * MiB;
constexpr size_t W_IN = 0, W_PA = W_IN + (size_t)NIN * 1024, W_PB = W_PA + 1024 * 256, W_O = W_PB + 1024 * 512, W_UP = W_O + 1024 * 1024, W_DN = W_UP + (size_t)NUP * 1024;
constexpr int LDS_BYTES = 128 * 1024 + 1024;

struct P {
    const float *x, *norm1_w, *w_in, *dn_conv_w, *dn_a_log, *dn_dt_bias, *dn_onorm_w, *w_pa, *w_pb, *w_o, *norm2_w, *w_up, *ffn_conv_w, *ffn_conv_b, *w_down, *final_norm_w;
    float* out; unsigned char* ws;
};

DI int tidx() { int t = threadIdx.x; asm volatile("" : "+v"(t)); return t; }
DI void lds_barrier() { asm volatile("s_waitcnt lgkmcnt(0)" ::: "memory"); __builtin_amdgcn_s_barrier(); asm volatile("" ::: "memory"); }
DI bf16_t f2bf(float f) { unsigned u = __float_as_uint(f); u += 0x7fffu + ((u >> 16) & 1u); return (bf16_t)(u >> 16); }
DI float bf2f(bf16_t b) { return __uint_as_float(((unsigned)b) << 16); }
typedef float f32x2 __attribute__((ext_vector_type(2)));
typedef __bf16 bf16x2v __attribute__((ext_vector_type(2)));
DI unsigned pk2(float a, float b) { const f32x2 v = {a, b}; return __builtin_bit_cast(unsigned, __builtin_convertvector(v, bf16x2v)); }
DI float lo_f(unsigned u) { return __uint_as_float(u << 16); }
DI float hi_f(unsigned u) { return __uint_as_float(u & 0xffff0000u); }
DI float sigmoidf_(float x) { return 1.f / (1.f + expf(-x)); }
DI float siluf_(float x) { return x / (1.f + expf(-x)); }
DI float fsilu(float x) { return x * __builtin_amdgcn_rcpf(1.f + __builtin_amdgcn_exp2f(-1.44269504089f * x)); }
DI float fsigmoid(float x) { return __builtin_amdgcn_rcpf(1.f + __builtin_amdgcn_exp2f(-1.44269504089f * x)); }
template <int CTRL, int RM, bool BC> DI float dpp_add_src(float v) { return __builtin_bit_cast(float, __builtin_amdgcn_update_dpp(0, __builtin_bit_cast(int, v), CTRL, RM, 0xf, BC)); }
DI float wave_sum(float v) {
    v += dpp_add_src<0x111, 0xf, true>(v); v += dpp_add_src<0x112, 0xf, true>(v); v += dpp_add_src<0x114, 0xf, true>(v); v += dpp_add_src<0x118, 0xf, true>(v);
    v += dpp_add_src<0x142, 0xa, false>(v);
    v += dpp_add_src<0x143, 0xc, false>(v);
    return __builtin_bit_cast(float, __builtin_amdgcn_readlane(__builtin_bit_cast(int, v), 63));
}
DI u32x4 pack8(f32x4 lo, f32x4 hi) { u32x4 w; w.x = pk2(lo.x, lo.y); w.y = pk2(lo.z, lo.w); w.z = pk2(hi.x, hi.y); w.w = pk2(hi.z, hi.w); return w; }
DI void unpack8(u32x4 v, float* f) { f[0] = lo_f(v.x); f[1] = hi_f(v.x); f[2] = lo_f(v.y); f[3] = hi_f(v.y); f[4] = lo_f(v.z); f[5] = hi_f(v.z); f[6] = lo_f(v.w); f[7] = hi_f(v.w); }

struct CvtTile { const float* src; bf16_t* dst; int K; };
DI bool cvt_tile(const P& p, int l, int it, CvtTile& t, int& ldn) {
    bf16_t* WB = (bf16_t*)(p.ws + O_W);
    const int n_in = (1024 / 64) * (NIN / 64), n_pa = (256 / 64) * (1024 / 64), n_pb = (512 / 64) * (1024 / 64), n_o = 16 * 16, n_up = 16 * (NUP / 64), n_dn = (DFF / 64) * 16;
    const int total = n_in + n_pa + n_pb + n_o + n_up + n_dn;
    if (it >= total) return false;
    int r = it; const float* W; int K, N, skip = 1 << 30; bf16_t* WT;
    if (r < n_in) { W = p.w_in + (size_t)l * 1024 * INW; K = 1024; N = NIN; ldn = INW; skip = 3840; WT = WB + W_IN; }
    else if ((r -= n_in) < n_pa) { W = p.w_pa + (size_t)l * 256 * 1024; K = 256; N = 1024; ldn = 1024; WT = WB + W_PA; }
    else if ((r -= n_pa) < n_pb) { W = p.w_pb + (size_t)l * 512 * 1024; K = 512; N = 1024; ldn = 1024; WT = WB + W_PB; }
    else if ((r -= n_pb) < n_o) { W = p.w_o + (size_t)l * 1024 * 1024; K = 1024; N = 1024; ldn = 1024; WT = WB + W_O; }
    else if ((r -= n_o) < n_up) { W = p.w_up + (size_t)l * 1024 * NUP; K = 1024; N = NUP; ldn = NUP; WT = WB + W_UP; }
    else { r -= n_up; W = p.w_down + (size_t)l * DFF * 1024; K = DFF; N = 1024; ldn = 1024; WT = WB + W_DN; }
    const int nnt = N / 64, kt = r / nnt, nt = r % nnt, n0 = nt * 64, k0 = kt * 64;
    int ns = n0 >= skip ? n0 + 8 : n0;
    if (N == NUP) { const int tt = n0 >> 8, o = n0 & 255; ns = o < 128 ? 128 * tt + o : DFF + 128 * tt + (o - 128); }
    t.src = W + (size_t)k0 * ldn + ns; t.dst = WT + (size_t)n0 * K + k0; t.K = K;
    return true;
}
constexpr int CVT_EARLY = (1024 / 64) * (NIN / 64) + (256 / 64) * 16;
constexpr int CVT_TOTAL = CVT_EARLY + (512 / 64) * 16 + 16 * 16 + 16 * (NUP / 64) + (DFF / 64) * 16;
DI void ph_convert(const P& p, int l, unsigned char* lds, int it0, int it1, int bid, int nblk) {
    float* tile = (float*)lds;
    CvtTile cur, nxt; int ldn = 0, ldn2 = 0;
    f32x4 r0, r1;
    const int per = (it1 - it0 + nblk - 1) / nblk, ib = it0 + bid * per, ie = (ib + per < it1) ? ib + per : it1;
    bool have = (ib < ie) && cvt_tile(p, l, ib, cur, ldn);
    { const int tid = tidx(), kr = tid >> 4, n4 = (tid & 15) * 4;
      if (have) { r0 = *(const f32x4*)(cur.src + (size_t)kr * ldn + n4); r1 = *(const f32x4*)(cur.src + (size_t)(kr + 32) * ldn + n4); } }
    for (int it = ib; have; ++it) {
        const int tid = tidx(), kr = tid >> 4, n4 = (tid & 15) * 4;
#pragma unroll
        for (int e = 0; e < 4; ++e) { tile[kr * 65 + n4 + e] = r0[e]; tile[(kr + 32) * 65 + n4 + e] = r1[e]; }
        lds_barrier();
        const bool hn = (it + 1 < ie) && cvt_tile(p, l, it + 1, nxt, ldn2);
        if (hn) { r0 = *(const f32x4*)(nxt.src + (size_t)kr * ldn2 + n4); r1 = *(const f32x4*)(nxt.src + (size_t)(kr + 32) * ldn2 + n4); }
        { const int n = tid >> 3, k8 = (tid & 7) * 8;
          const float* tp = tile + k8 * 65 + n;
          *(u32x4*)(cur.dst + (size_t)n * cur.K + k8) = pack8((f32x4){tp[0], tp[65], tp[130], tp[195]}, (f32x4){tp[260], tp[325], tp[390], tp[455]}); }
        lds_barrier();
        cur = nxt; ldn = ldn2; have = hn;
    }
}

template <bool SRCBF> DI void ph_rmsnorm(const P& p, const void* __restrict__ src_, const float* __restrict__ w, int bg_layer, unsigned char* lds_) {
    const float* src = (const float*)src_; const bf16_t* srcb = (const bf16_t*)src_;
    const int lane = tidx() & 63, wave = tidx() >> 6;
    bf16_t* XN = (bf16_t*)(p.ws + O_XN);
    float* BG = (float*)(p.ws + O_BG);
    float* tbl = (float*)lds_;
    if (bg_layer >= 0) {
        const float* wi = p.w_in + (size_t)bg_layer * 1024 * INW + 3840;
        const int tid = tidx();
#pragma unroll
        for (int i = 0; i < 4; ++i) { const int idx = tid + 512 * i, k = idx >> 1, hf = idx & 1;
            const f32x4 v = *(const f32x4*)(wi + (size_t)k * INW + 4 * hf);
#pragma unroll
            for (int e = 0; e < 4; ++e) tbl[(4 * hf + e) * 1024 + k] = v[e]; }
        __syncthreads();
    }
    for (int row = blockIdx.x * 8 + wave; row < T_; row += gridDim.x * 8) {
        f32x4 v[4]; float ss = 0.f;
        if (SRCBF) { const u32x2* xb = (const u32x2*)(srcb + (size_t)row * DM) + lane;
#pragma unroll
            for (int j = 0; j < 4; ++j) { const u32x2 q = xb[64 * j]; v[j] = (f32x4){lo_f(q.x), hi_f(q.x), lo_f(q.y), hi_f(q.y)}; } }
        else { const f32x4* xr = (const f32x4*)(src + (size_t)row * DM) + lane;
#pragma unroll
            for (int j = 0; j < 4; ++j) v[j] = xr[64 * j]; }
#pragma unroll
        for (int j = 0; j < 4; ++j) ss += v[j].x * v[j].x + v[j].y * v[j].y + v[j].z * v[j].z + v[j].w * v[j].w;
        ss = wave_sum(ss);
        const float r = 1.f / sqrtf(ss * (1.f / DM) + 1e-6f);
#pragma unroll
        for (int j = 0; j < 4; ++j) { const f32x4 ww = ((const f32x4*)w)[lane + 64 * j]; v[j] = v[j] * r * ww; }
        u32x2* o = (u32x2*)(XN + (size_t)row * DM) + lane;
#pragma unroll
        for (int j = 0; j < 4; ++j) { u32x2 q; q.x = pk2(v[j].x, v[j].y); q.y = pk2(v[j].z, v[j].w); o[64 * j] = q; }
        if (bg_layer >= 0) {
            float a[8];
#pragma unroll
            for (int c = 0; c < 8; ++c) { a[c] = 0.f;
#pragma unroll
                for (int j = 0; j < 4; ++j) { const f32x4 tw = *(const f32x4*)(tbl + c * 1024 + 4 * (lane + 64 * j)); a[c] += v[j].x * tw.x + v[j].y * tw.y + v[j].z * tw.z + v[j].w * tw.w; } }
#pragma unroll
            for (int c = 0; c < 8; ++c) a[c] = wave_sum(a[c]);
            if (lane == 0) {
                const float* alog = p.dn_a_log + bg_layer * 4; const float* dtb = p.dn_dt_bias + bg_layer * 4;
                float o8[8];
#pragma unroll
                for (int h = 0; h < 4; ++h) {
                    o8[h] = sigmoidf_(a[h]);
                    const float z = a[4 + h] + dtb[h];
                    const float sp = z > 20.f ? z : log1pf(expf(z));
                    o8[4 + h] = -expf(alog[h]) * sp;
                }
                f32x4* bo = (f32x4*)(BG + (size_t)row * 8);
                bo[0] = (f32x4){o8[0], o8[1], o8[2], o8[3]}; bo[1] = (f32x4){o8[4], o8[5], o8[6], o8[7]};
            }
        }
    }
}

template <class Epi>
DI void gemm_nv(const bf16_t* __restrict__ A, const bf16_t* __restrict__ WT, int M, int N, int K, const Epi& epi) {
    const int lane = tidx() & 63, wave = tidx() >> 6, fr = lane & 15, fq = lane >> 4;
    const int nMt = M / 32, nNt = N / 64, nU = nMt * nNt;
    for (int u = blockIdx.x * 8 + wave; u < nU; u += gridDim.x * 8) {
        const int mt = u % nMt, nt = u / nMt, row0 = mt * 32, col0 = nt * 64;
        f32x4 acc[2][2][2];
#pragma unroll
        for (int m = 0; m < 2; ++m)
#pragma unroll
            for (int g = 0; g < 2; ++g)
#pragma unroll
                for (int nb = 0; nb < 2; ++nb) acc[m][g][nb] = (f32x4){0.f, 0.f, 0.f, 0.f};
        const bf16_t* ap0 = A + (size_t)(row0 + fr) * K + 8 * fq;
        const bf16_t* ap1 = ap0 + (size_t)16 * K;
        const bf16_t* wp00 = WT + (size_t)(col0 + 8 * (fr >> 2) + (fr & 3)) * K + 8 * fq;
        const bf16_t* wp01 = wp00 + (size_t)4 * K;
        const bf16_t* wp10 = wp00 + (size_t)32 * K;
        const bf16_t* wp11 = wp10 + (size_t)4 * K;
#pragma unroll 2
        for (int k0 = 0; k0 < K; k0 += 32) {
            const bf16x8 a0 = *(const bf16x8*)(ap0 + k0), a1 = *(const bf16x8*)(ap1 + k0);
            const bf16x8 w00 = *(const bf16x8*)(wp00 + k0), w01 = *(const bf16x8*)(wp01 + k0), w10 = *(const bf16x8*)(wp10 + k0), w11 = *(const bf16x8*)(wp11 + k0);
            acc[0][0][0] = __builtin_amdgcn_mfma_f32_16x16x32_bf16(w00, a0, acc[0][0][0], 0, 0, 0);
            acc[0][0][1] = __builtin_amdgcn_mfma_f32_16x16x32_bf16(w01, a0, acc[0][0][1], 0, 0, 0);
            acc[0][1][0] = __builtin_amdgcn_mfma_f32_16x16x32_bf16(w10, a0, acc[0][1][0], 0, 0, 0);
            acc[0][1][1] = __builtin_amdgcn_mfma_f32_16x16x32_bf16(w11, a0, acc[0][1][1], 0, 0, 0);
            acc[1][0][0] = __builtin_amdgcn_mfma_f32_16x16x32_bf16(w00, a1, acc[1][0][0], 0, 0, 0);
            acc[1][0][1] = __builtin_amdgcn_mfma_f32_16x16x32_bf16(w01, a1, acc[1][0][1], 0, 0, 0);
            acc[1][1][0] = __builtin_amdgcn_mfma_f32_16x16x32_bf16(w10, a1, acc[1][1][0], 0, 0, 0);
            acc[1][1][1] = __builtin_amdgcn_mfma_f32_16x16x32_bf16(w11, a1, acc[1][1][1], 0, 0, 0);
        }
#pragma unroll
        for (int m = 0; m < 2; ++m)
#pragma unroll
            for (int g = 0; g < 2; ++g) epi(row0 + 16 * m + fr, col0 + 32 * g + 8 * fq, acc[m][g][0], acc[m][g][1]);
    }
}

struct EpiIn {
    bf16_t *QKV, *DQKV, *DZ, *SG; int coff;
    struct Pre {}; DI Pre load(int, int) const { return Pre{}; }
    DI void apply(int row, int col, f32x4 lo, f32x4 hi, const Pre&) const { (*this)(row, col + coff, lo, hi); }
    DI void operator()(int row, int col, f32x4 lo, f32x4 hi) const {
        if (col < 2304) *(u32x4*)(QKV + (size_t)row * 2304 + col) = pack8(lo, hi);
        else if (col < 3840) *(u32x4*)(DQKV + (size_t)row * 1536 + (col - 2304)) = pack8(lo, hi);
        else if (col < 4352) *(u32x4*)(DZ + (size_t)row * 512 + (col - 3840)) = pack8(lo, hi);
        else {
#pragma unroll
            for (int e = 0; e < 4; ++e) { lo[e] = fsigmoid(lo[e]); hi[e] = fsigmoid(hi[e]); }
            *(u32x4*)(SG + (size_t)row * 2048 + (col - 4352)) = pack8(lo, hi);
        }
    }
};
template <int ADD> struct EpiGate {
    bf16_t* Y; const bf16_t* SG; int goff;
    struct Pre { u32x4 g, y; };
    DI Pre load(int row, int col) const { Pre q; q.g = *(const u32x4*)(SG + (size_t)row * 2048 + goff + col); if (ADD) q.y = *(const u32x4*)(Y + (size_t)row * DM + col); else q.y = (u32x4){0u, 0u, 0u, 0u}; return q; }
    DI void apply(int row, int col, f32x4 lo, f32x4 hi, const Pre& q) const {
        float g[8], o[8]; unpack8(q.g, g); unpack8(q.y, o);
        f32x4 a, b;
#pragma unroll
        for (int e = 0; e < 4; ++e) { a[e] = g[e] * lo[e] + o[e]; b[e] = g[4 + e] * hi[e] + o[4 + e]; }
        *(u32x4*)(Y + (size_t)row * DM + col) = pack8(a, b);
    }
};
struct EpiRes {
    const float* X; float* R;
    struct Pre { f32x4 x0, x1; };
    DI Pre load(int row, int col) const { const f32x4* xp = (const f32x4*)(X + (size_t)row * DM + col); Pre q; q.x0 = xp[0]; q.x1 = xp[1]; return q; }
    DI void apply(int row, int col, f32x4 lo, f32x4 hi, const Pre& q) const { f32x4* rp = (f32x4*)(R + (size_t)row * DM + col); rp[0] = q.x0 + lo; rp[1] = q.x1 + hi; }
};
template <bool XF32> struct EpiResB {
    const void* X; bf16_t* R;
    struct Pre { f32x4 x0, x1; };
    DI Pre load(int row, int col) const {
        Pre q;
        if (XF32) { const f32x4* xp = (const f32x4*)((const float*)X + (size_t)row * DM + col); q.x0 = xp[0]; q.x1 = xp[1]; }
        else { const u32x4 u = *(const u32x4*)((const bf16_t*)X + (size_t)row * DM + col); q.x0 = (f32x4){lo_f(u.x), hi_f(u.x), lo_f(u.y), hi_f(u.y)}; q.x1 = (f32x4){lo_f(u.z), hi_f(u.z), lo_f(u.w), hi_f(u.w)}; }
        return q;
    }
    DI void apply(int row, int col, f32x4 lo, f32x4 hi, const Pre& q) const { *(u32x4*)(R + (size_t)row * DM + col) = pack8(q.x0 + lo, q.x1 + hi); }
};
struct EpiUp {
    bf16_t* U;
    struct Pre {}; DI Pre load(int, int) const { return Pre{}; }
    DI void apply(int row, int col, f32x4 lo, f32x4 hi, const Pre&) const { (*this)(row, col, lo, hi); }
    DI void operator()(int row, int col, f32x4 lo, f32x4 hi) const { *(u32x4*)(U + (size_t)row * NUP + col) = pack8(lo, hi); }
};

namespace pg8 {
#define PG8_LAS __attribute__((address_space(3)))
typedef unsigned short bf16_t;
typedef short bf16x8 __attribute__((ext_vector_type(8)));
typedef float f32x4 __attribute__((ext_vector_type(4)));
typedef unsigned u32x4 __attribute__((ext_vector_type(4)));
constexpr int BM = 256, BK = 64, HALF = 128, HTB = HALF * BK * 2  , STAGE_BYTES = 8 * HTB, NXCD = 8, WGM = 8;

__host__ __device__ __forceinline__ int lds_byte(int r, int c) { const int st = (r >> 4) * 2 + (c >> 5), rr = r & 15, cc = c & 31, ob = rr * 64 + cc * 2; return st * 1024 + (ob ^ (((ob >> 9) & 1) << 5)); }
__host__ __device__ __forceinline__ void stage_rc(int b, int& R, int& C) { const int st = b / 1024, sb = b % 1024, swz = sb ^ (((sb >> 9) & 1) << 5); R = (st >> 1) * 16 + swz / 64; C = (st & 1) * 32 + (swz % 64) / 2; }
__host__ __device__ __forceinline__ int perm32(int rho) { const int n = rho >> 4, i = rho & 15; return 8 * (i >> 2) + 4 * n + (i & 3); }

struct Unit { int pm, pn; };
struct Gemm { const bf16_t* A; const bf16_t* Bt; int M, N, K; };
struct StaticOrder {
    int nM, nN, nwg, G, c;
    __host__ __device__ void init(int M, int N, int G_, int c_) { nM = M / BM; nN = N / BM; nwg = nM * nN; G = G_; c = c_; }
    __host__ __device__ bool next(int i, Unit& u) const {
        const long L = (long)i * G + c; if (L >= nwg) return false;
        int wgid = (int)L; { const int q = nwg / NXCD, r = nwg % NXCD, xcd = wgid % NXCD, off = wgid / NXCD; wgid = (xcd < r ? xcd * (q + 1) : r * (q + 1) + (xcd - r) * q) + off; }
        const int nig = WGM * nN, gid = wgid / nig, fm = gid * WGM, gsz = (nM - fm) < WGM ? (nM - fm) : WGM;
        u.pm = fm + ((wgid % nig) % gsz); u.pn = (wgid % nig) / gsz; return true;
    }
    __device__ __forceinline__ void a_ready(const Unit&) const {}
    __device__ __forceinline__ void done(const Unit&) const {}
};
template <class Epi, class Sched>
__device__ __forceinline__ void gemm_phase(PG8_LAS unsigned char* lds, const Gemm g, const Sched& S, const Epi& E) {
    int tid_ = threadIdx.x; asm volatile("" : "+v"(tid_));
    const int tid = tid_, wid = __builtin_amdgcn_readfirstlane(tid >> 6), lane = tid & 63, wr = wid >> 2, wc = wid & 3, fr = lane & 15, fq = lane >> 4;
    const int K = g.K, nt = K / BK;
    unsigned voffA[2], voffB[2];
#pragma unroll
    for (int i = 0; i < 2; ++i) { int R, C; stage_rc(tid * 16 + i * 8192, R, C); const int Rb = Epi::PERM ? ((R & ~31) + perm32(R & 31)) : R;
        voffA[i] = (unsigned)(R * K + C) * 2u; voffB[i] = (unsigned)(Rb * K + C) * 2u; }
    const size_t kstep = (size_t)(BK * 2);
    const size_t hstep = (size_t)HALF * K * 2;
    const size_t tstep = 2 * hstep;
    const unsigned ldsw = (unsigned)wid * 1024u;
    const int aoff = lds_byte(wr * 64 + fr, fq * 8), boff = lds_byte(wc * 32 + fr, fq * 8);
#define PG8_SA(b, h) (((b) * 2 + (h)) * HTB)
#define PG8_SB(b, h) ((4 + (b) * 2 + (h)) * HTB)
#define PG8_STAGE(bufoff, gbase, voff) do { _Pragma("unroll") for (int _i = 0; _i < 2; ++_i) \
        __builtin_amdgcn_global_load_lds((const unsigned*)((const char*)(gbase) + (voff)[_i]), (PG8_LAS unsigned*)(lds + (bufoff) + ldsw + _i * 8192), 16, 0, 0); } while (0)
#define PG8_LDA(dst, b, h) do { _Pragma("unroll") for (int m = 0; m < 4; ++m) _Pragma("unroll") for (int k = 0; k < 2; ++k) dst[m][k] = *(const PG8_LAS bf16x8*)(lds + PG8_SA(b, h) + aoff + m * 2048 + k * 1024); } while (0)
#define PG8_LDB(dst, b, h) do { _Pragma("unroll") for (int n = 0; n < 2; ++n) _Pragma("unroll") for (int k = 0; k < 2; ++k) dst[n][k] = *(const PG8_LAS bf16x8*)(lds + PG8_SB(b, h) + boff + n * 2048 + k * 1024); } while (0)
#define PG8_MMA(ai, bj, At, Bt) do { __builtin_amdgcn_s_setprio(1); _Pragma("unroll") for (int m = 0; m < 4; ++m) _Pragma("unroll") for (int n = 0; n < 2; ++n) _Pragma("unroll") for (int k = 0; k < 2; ++k) \
        acc[ai][bj][m][n] = __builtin_amdgcn_mfma_f32_16x16x32_bf16(Bt[n][k], At[m][k], acc[ai][bj][m][n], 0, 0, 0); __builtin_amdgcn_s_setprio(0); } while (0)
#define PG8_WAIT_V(n) asm volatile("s_waitcnt vmcnt(" #n ")" ::: "memory")
#define PG8_WAIT_L(n) asm volatile("s_waitcnt lgkmcnt(" #n ")" ::: "memory")
#define PG8_BAR __builtin_amdgcn_s_barrier()
#define PG8_SCHED __builtin_amdgcn_sched_barrier(0)
    Unit cur, nxt; int ui = 0;
    if (!S.next(0, cur)) return;
    f32x4 acc[2][2][4][2];
#pragma unroll
    for (int a = 0; a < 2; ++a)
#pragma unroll
        for (int b = 0; b < 2; ++b)
#pragma unroll
            for (int m = 0; m < 4; ++m)
#pragma unroll
                for (int n = 0; n < 2; ++n) acc[a][b][m][n] = (f32x4){0.f, 0.f, 0.f, 0.f};
    bf16x8 At[4][2], B0[2][2], B1[2][2];
    const char* cA = (const char*)g.A + (size_t)cur.pm * tstep; const char* cB = (const char*)g.Bt + (size_t)cur.pn * tstep;
    S.a_ready(cur);
    PG8_STAGE(PG8_SB(0, 0), cB, voffB); PG8_STAGE(PG8_SA(0, 0), cA, voffA); PG8_STAGE(PG8_SB(0, 1), cB + hstep, voffB); PG8_STAGE(PG8_SA(0, 1), cA + hstep, voffA);
    if (wr == 1) PG8_BAR;
    PG8_WAIT_V(4); PG8_BAR;
    PG8_STAGE(PG8_SB(1, 0), cB + kstep, voffB); PG8_STAGE(PG8_SA(1, 0), cA + kstep, voffA); PG8_STAGE(PG8_SB(1, 1), cB + hstep + kstep, voffB);
    PG8_WAIT_V(6); PG8_BAR;
    for (;;) {
        const bool has_next = S.next(ui + 1, nxt);
        const char* nA = has_next ? (const char*)g.A + (size_t)nxt.pm * tstep : cA; const char* nB = has_next ? (const char*)g.Bt + (size_t)nxt.pn * tstep : cB;
        for (int t = 0; t < nt; t += 2) {
            const bool last = (t == nt - 2);
            const char* a1 = cA + (size_t)(t + 1) * kstep;
            const char* a2 = last ? nA : cA + (size_t)(t + 2) * kstep; const char* b2 = last ? nB : cB + (size_t)(t + 2) * kstep;
            const char* a3 = a2 + kstep; const char* b3 = b2 + kstep;
            if (last && has_next) S.a_ready(nxt);
            PG8_LDB(B0, 0, 0); PG8_SCHED; PG8_LDA(At, 0, 0); PG8_STAGE(PG8_SA(1, 1), a1 + hstep, voffA);
            PG8_WAIT_L(8); PG8_BAR; PG8_WAIT_L(0); PG8_MMA(0, 0, At, B0); PG8_BAR; PG8_SCHED;
            PG8_LDB(B1, 0, 1); PG8_STAGE(PG8_SB(0, 0), b2, voffB);
            PG8_BAR; PG8_WAIT_L(0); PG8_MMA(0, 1, At, B1); PG8_BAR;
            PG8_LDA(At, 0, 1); PG8_STAGE(PG8_SA(0, 0), a2, voffA);
            PG8_BAR; PG8_WAIT_L(0); PG8_MMA(1, 0, At, B0); PG8_BAR; PG8_SCHED;
            PG8_STAGE(PG8_SB(0, 1), b2 + hstep, voffB);
            PG8_WAIT_V(6); PG8_BAR; PG8_MMA(1, 1, At, B1); PG8_BAR;
            PG8_LDB(B0, 1, 0); PG8_SCHED; PG8_LDA(At, 1, 0); PG8_STAGE(PG8_SA(0, 1), a2 + hstep, voffA);
            PG8_WAIT_L(8); PG8_BAR; PG8_WAIT_L(0); PG8_MMA(0, 0, At, B0); PG8_BAR; PG8_SCHED;
            PG8_LDB(B1, 1, 1); PG8_STAGE(PG8_SB(1, 0), b3, voffB);
            PG8_BAR; PG8_WAIT_L(0); PG8_MMA(0, 1, At, B1); PG8_BAR;
            PG8_LDA(At, 1, 1); PG8_STAGE(PG8_SA(1, 0), a3, voffA);
            PG8_BAR; PG8_WAIT_L(0); PG8_MMA(1, 0, At, B0); PG8_BAR; PG8_SCHED;
            PG8_STAGE(PG8_SB(1, 1), b3 + hstep, voffB);
            PG8_WAIT_V(6); PG8_BAR; PG8_MMA(1, 1, At, B1); PG8_BAR;
        }
        if constexpr (!Epi::AFTER_DRAIN) { E(acc, cur, wr, wc, fr, fq); S.done(cur); }
        if (!has_next) break;
#pragma unroll
        for (int a = 0; a < 2; ++a)
#pragma unroll
            for (int b = 0; b < 2; ++b)
#pragma unroll
                for (int m = 0; m < 4; ++m)
#pragma unroll
                    for (int n = 0; n < 2; ++n) acc[a][b][m][n] = (f32x4){0.f, 0.f, 0.f, 0.f};
        cur = nxt; cA = nA; cB = nB; ++ui;
    }
    PG8_WAIT_V(0);
    if (wr == 0) PG8_BAR;
    PG8_BAR;
    if constexpr (Epi::AFTER_DRAIN) { E.fused(acc, cur, wr, wc, fr, fq, lds, wid, lane); S.done(cur); }
#undef PG8_SA
#undef PG8_SB
#undef PG8_STAGE
#undef PG8_LDA
#undef PG8_LDB
#undef PG8_MMA
#undef PG8_WAIT_V
#undef PG8_WAIT_L
#undef PG8_BAR
#undef PG8_SCHED
}
}

template <class F> struct EpiAdapt {
    static constexpr bool PERM = true, AFTER_DRAIN = false;
    F f;
    DI void operator()(const pg8::f32x4 (&acc)[2][2][4][2], const pg8::Unit& u, int wr, int wc, int fr, int fq) const {
        const int row0 = u.pm * 256 + wr * 64 + fr, col0 = u.pn * 256 + wc * 32 + 8 * fq;
#pragma unroll
        for (int ai = 0; ai < 2; ++ai) {
            typename F::Pre pre[4][2];
#pragma unroll
            for (int m = 0; m < 4; ++m)
#pragma unroll
                for (int bj = 0; bj < 2; ++bj) pre[m][bj] = f.load(row0 + ai * 128 + m * 16, col0 + bj * 128);
#pragma unroll
            for (int m = 0; m < 4; ++m)
#pragma unroll
                for (int bj = 0; bj < 2; ++bj) f.apply(row0 + ai * 128 + m * 16, col0 + bj * 128, acc[ai][bj][m][0], acc[ai][bj][m][1], pre[m][bj]);
            if constexpr (sizeof(typename F::Pre) > 1) { asm volatile("" ::: "memory"); __builtin_amdgcn_sched_barrier(0); }
        }
    }
};
template <class F> DI void gemm_fast(unsigned char* lds, const bf16_t* A, const bf16_t* WT, int M, int N, int K, const F& f) {
    asm volatile("" : "+s"(K));
    pg8::Gemm g{A, WT, M, N, K}; pg8::StaticOrder S; S.init(M, N, (int)gridDim.x, (int)blockIdx.x);
    EpiAdapt<F> E{f};
    pg8::gemm_phase((PG8_LAS unsigned char*)lds, g, S, E);
}
#ifndef FAST_GEMM
#define FAST_GEMM 1
#endif
#if FAST_GEMM
#define GEMM(A, W, M, N, K, e) gemm_fast(lds, A, W, M, N, K, e)
#else
#define GEMM(A, W, M, N, K, e) gemm_nv(A, W, M, N, K, e)
#endif

DI void ph_attn_naive(const P& p) {
    const bf16_t* QKV = (const bf16_t*)(p.ws + O_QKV); bf16_t* OG = (bf16_t*)((unsigned char*)p.out + 64 * MiB); float* LSE = (float*)((unsigned char*)p.out + 112 * MiB);
    for (int it = blockIdx.x * NT + tidx(); it < T_ * 12; it += gridDim.x * NT) {
        const int t = it / 12, gh = it % 12, g = gh >> 2, h = gh & 3;
        const int d = g == 0 ? 1 : (g == 1 ? 4 : 16);
        const int pos = t % S_;
        int nk = pos / d; nk = (nk > 128 ? 128 : nk) + 1;
        float q[64], o[64];
        const bf16_t* qp = QKV + (size_t)t * 2304 + g * 256 + h * 64;
#pragma unroll
        for (int i = 0; i < 8; ++i) unpack8(((const u32x4*)qp)[i], q + 8 * i);
#pragma unroll
        for (int i = 0; i < 64; ++i) o[i] = 0.f;
        float m = -1e30f, den = 0.f;
        for (int j = 0; j < nk; ++j) {
            const bf16_t* kp = QKV + (size_t)(t - j * d) * 2304 + 768 + g * 256 + h * 64;
            float s = 0.f;
#pragma unroll
            for (int i = 0; i < 8; ++i) { float kk[8]; unpack8(((const u32x4*)kp)[i], kk);
#pragma unroll
                for (int e = 0; e < 8; ++e) s += q[8 * i + e] * kk[e]; }
            s *= 0.125f;
            const float mn = fmaxf(m, s), corr = expf(m - mn), pj = expf(s - mn);
            den = den * corr + pj; m = mn;
            const bf16_t* vp = kp + 768;
#pragma unroll
            for (int i = 0; i < 8; ++i) { float vv[8]; unpack8(((const u32x4*)vp)[i], vv);
#pragma unroll
                for (int e = 0; e < 8; ++e) o[8 * i + e] = o[8 * i + e] * corr + pj * vv[e]; }
        }
        const float inv = 1.f / den;
        bf16_t* op = OG + ((size_t)g * T_ + t) * 256 + h * 64;
#pragma unroll
        for (int i = 0; i < 8; ++i) { u32x4 w; w.x = pk2(o[8 * i] * inv, o[8 * i + 1] * inv); w.y = pk2(o[8 * i + 2] * inv, o[8 * i + 3] * inv); w.z = pk2(o[8 * i + 4] * inv, o[8 * i + 5] * inv); w.w = pk2(o[8 * i + 6] * inv, o[8 * i + 7] * inv); ((u32x4*)op)[i] = w; }
        LSE[((size_t)g * T_ + t) * 4 + h] = m + logf(den);
    }
}

DI void ph_dn_naive(const P& p, int l, unsigned char* lds_, float* __restrict__ OB) {
    float* kq = (float*)lds_;
    float* red = kq + 2 * 2 * 128;
    const bf16_t* DQKV = (const bf16_t*)(p.ws + O_DQKV); const float* BG = (const float*)(p.ws + O_BG);
    const int tid = tidx(), c = tid >> 2, part = tid & 3, wig = tid >> 6, lane = tid & 63;
    for (int pair = blockIdx.x; pair < 32; pair += gridDim.x) {
        const int b = pair >> 2, h = pair & 3;
        const float* cw = p.dn_conv_w + (size_t)l * 4 * 1536 + h * 128 + c;
        float wq[4], wk[4], wv[4];
#pragma unroll
        for (int j = 0; j < 4; ++j) { wq[j] = cw[j * 1536]; wk[j] = cw[j * 1536 + 512]; wv[j] = cw[j * 1536 + 1024]; }
        float hq0 = 0.f, hq1 = 0.f, hq2 = 0.f, hk0 = 0.f, hk1 = 0.f, hk2 = 0.f, hv0 = 0.f, hv1 = 0.f, hv2 = 0.f;
        float s[32];
#pragma unroll
        for (int i = 0; i < 32; ++i) s[i] = 0.f;
        const bf16_t* dp = DQKV + (size_t)(b * S_) * 1536 + h * 128 + c;
        bf16_t nq = dp[0], nk = dp[512], nv = dp[1024];
        for (int t = 0; t < S_; ++t) {
            const size_t row = (size_t)b * S_ + t;
            const float xq = bf2f(nq), xk = bf2f(nk), xv = bf2f(nv);
            if (t + 1 < S_) { const bf16_t* np = dp + (size_t)(t + 1) * 1536; nq = np[0]; nk = np[512]; nv = np[1024]; }
            float cq = wq[0] * hq0 + wq[1] * hq1 + wq[2] * hq2 + wq[3] * xq;
            float ck = wk[0] * hk0 + wk[1] * hk1 + wk[2] * hk2 + wk[3] * xk;
            float cv = wv[0] * hv0 + wv[1] * hv1 + wv[2] * hv2 + wv[3] * xv;
            hq0 = hq1; hq1 = hq2; hq2 = xq; hk0 = hk1; hk1 = hk2; hk2 = xk; hv0 = hv1; hv1 = hv2; hv2 = xv;
            cq = siluf_(cq); ck = siluf_(ck); cv = siluf_(cv);
            float sq = wave_sum(part ? 0.f : cq * cq), sk = wave_sum(part ? 0.f : ck * ck);
            const int par = t & 1;
            float* rd = red + par * 16;
            if (lane == 0) { rd[wig * 2] = sq; rd[wig * 2 + 1] = sk; }
            __syncthreads();
            sq = 0.f; sk = 0.f;
#pragma unroll
            for (int w = 0; w < 8; ++w) { sq += rd[2 * w]; sk += rd[2 * w + 1]; }
            const float qn = cq * (1.f / sqrtf(sq + 1e-6f)) * 0.08838834764831845f, kn = ck * (1.f / sqrtf(sk + 1e-6f));
            float* kb = kq + par * 256; float* qb = kb + 128;
            if (!part) { kb[c] = kn; qb[c] = qn; }
            __syncthreads();
            const float beta = BG[row * 8 + h], eg = expf(BG[row * 8 + 4 + h]);
            const float* kbh = kb + part * 32; const float* qbh = qb + part * 32;
            float kS = 0.f;
#pragma unroll
            for (int i = 0; i < 32; ++i) kS += kbh[i] * s[i];
            kS += __shfl_xor(kS, 1); kS += __shfl_xor(kS, 2);
            const float coef = beta * (cv - eg * kS);
            float o = 0.f;
#pragma unroll
            for (int i = 0; i < 32; ++i) { s[i] = eg * s[i] + kbh[i] * coef; o += qbh[i] * s[i]; }
            o += __shfl_xor(o, 1); o += __shfl_xor(o, 2);
            if (!part) OB[row * 512 + h * 128 + c] = o;
        }
    }
}


constexpr size_t O_PW = O_QKV, O_PQD = O_QKV + 8192 * 2, O_PKDT = O_QKV + 16384 * 2, O_PUT = O_QKV + 24576 * 2, O_PQK = O_QKV + 32768 * 2;
constexpr size_t RS = 36864;
#define MFMA16(a, b, c) __builtin_amdgcn_mfma_f32_16x16x32_bf16((a), (b), (c), 0, 0, 0)
DI void ph_dn_prep(const P& p, int l, unsigned char* lds_) {
    bf16_t* Qt = (bf16_t*)lds_;
    bf16_t* Kt = Qt + 64 * 136;
    bf16_t* VBT = Kt + 64 * 136;
    bf16_t* KBGT = VBT + 128 * 72;
    bf16_t* AI = KBGT + 128 * 72;
    float* Mf = (float*)(AI + 64 * 72);
    float* gcs = Mf + 64 * 68;
    const bf16_t* DQKV = (const bf16_t*)(p.ws + O_DQKV); const float* BG = (const float*)(p.ws + O_BG);
    bf16_t* PW = (bf16_t*)(p.ws + O_PW); bf16_t* PQD = (bf16_t*)(p.ws + O_PQD); bf16_t* PKDT = (bf16_t*)(p.ws + O_PKDT); bf16_t* PUT = (bf16_t*)(p.ws + O_PUT); bf16_t* PQK = (bf16_t*)(p.ws + O_PQK);
    float* GL = (float*)(p.ws + O_GL);
    for (int ci = blockIdx.x; ci < 2048; ci += gridDim.x) {
        const int tid = tidx(), lane = tid & 63, w = __builtin_amdgcn_readfirstlane(tid >> 6), fr = lane & 15, fq = lane >> 4;
        const int cg_ = tid % 48, tg = tid / 48, part = cg_ >> 4, c8 = (cg_ & 15) * 8;
        const int b = ci >> 8, h = (ci >> 6) & 3, n = ci & 63;
        const size_t row0 = (size_t)b * S_ + n * 64;
        u32x4 raw[11];
        if (tid >= 448) {
            float x = BG[(row0 + lane) * 8 + 4 + h];
            const float be = BG[(row0 + lane) * 8 + h];
#pragma unroll
            for (int o = 1; o < 64; o <<= 1) { const float v = __shfl_up(x, o); if (lane >= o) x += v; }
            gcs[lane] = x; gcs[64 + lane] = be;
        }
        if (tid < 384) {
#pragma unroll
            for (int r = 0; r < 11; ++r) {
                const int tk = tg * 8 - 3 + r;
                if (n * 64 + tk >= 0) raw[r] = *(const u32x4*)(DQKV + (row0 + tk) * 1536 + part * 512 + h * 128 + c8);
                else raw[r] = (u32x4){0u, 0u, 0u, 0u};
            }
        }
        lds_barrier();
        if (tid < 384) {
            const float* cwp = p.dn_conv_w + (size_t)l * 4 * 1536 + part * 512 + h * 128 + c8;
            float cw[4][8];
#pragma unroll
            for (int j = 0; j < 4; ++j) { const f32x4 a = *(const f32x4*)(cwp + j * 1536), bb = *(const f32x4*)(cwp + j * 1536 + 4);
                cw[j][0] = a.x; cw[j][1] = a.y; cw[j][2] = a.z; cw[j][3] = a.w; cw[j][4] = bb.x; cw[j][5] = bb.y; cw[j][6] = bb.z; cw[j][7] = bb.w; }
            float rn[8];
#pragma unroll
            for (int i = 0; i < 8; ++i) {
                float ss = 0.f;
#pragma unroll
                for (int e = 0; e < 8; ++e) {
                    float v = 0.f;
#pragma unroll
                    for (int j = 0; j < 4; ++j) { const unsigned u = raw[i + j][e >> 1]; v += cw[j][e] * ((e & 1) ? hi_f(u) : lo_f(u)); }
                    v = fsilu(v); ss += v * v;
                }
#pragma unroll
                for (int o = 1; o < 16; o <<= 1) ss += __shfl_xor(ss, o);
                rn[i] = part == 2 ? 1.f : (1.f / sqrtf(ss + 1e-6f)) * (part == 0 ? 0.08838834764831845f : 1.f);
            }
            const float gclast = gcs[63];
            float s1[8], s2[8];
#pragma unroll
            for (int i = 0; i < 8; ++i) { const int tok = tg * 8 + i; const float gc = gcs[tok], be = gcs[64 + tok];
                s1[i] = part == 0 ? expf(gc) : (part == 1 ? be * expf(gc) : be); s2[i] = expf(gclast - gc); }
#pragma unroll
            for (int hf = 0; hf < 2; ++hf) {
                float val[8][4];
#pragma unroll
                for (int i = 0; i < 8; ++i)
#pragma unroll
                    for (int e4 = 0; e4 < 4; ++e4) { const int e = 4 * hf + e4;
                        float v = 0.f;
#pragma unroll
                        for (int j = 0; j < 4; ++j) { const unsigned u = raw[i + j][e >> 1]; v += cw[j][e] * ((e & 1) ? hi_f(u) : lo_f(u)); }
                        val[i][e4] = fsilu(v) * rn[i]; }
                const int ch0 = c8 + 4 * hf;
                if (part == 0) {
#pragma unroll
                    for (int i = 0; i < 8; ++i) { const int tok = tg * 8 + i;
                        u32x2 a; a.x = pk2(val[i][0], val[i][1]); a.y = pk2(val[i][2], val[i][3]); *(u32x2*)(Qt + tok * 136 + ch0) = a;
                        u32x2 d; d.x = pk2(val[i][0] * s1[i], val[i][1] * s1[i]); d.y = pk2(val[i][2] * s1[i], val[i][3] * s1[i]); *(u32x2*)(PQD + (size_t)ci * RS + tok * 128 + ch0) = d; }
                } else if (part == 1) {
#pragma unroll
                    for (int i = 0; i < 8; ++i) { const int tok = tg * 8 + i;
                        u32x2 a; a.x = pk2(val[i][0], val[i][1]); a.y = pk2(val[i][2], val[i][3]); *(u32x2*)(Kt + tok * 136 + ch0) = a; }
#pragma unroll
                    for (int e4 = 0; e4 < 4; ++e4) {
                        *(u32x4*)(KBGT + (ch0 + e4) * 72 + tg * 8) = pack8((f32x4){val[0][e4] * s1[0], val[1][e4] * s1[1], val[2][e4] * s1[2], val[3][e4] * s1[3]}, (f32x4){val[4][e4] * s1[4], val[5][e4] * s1[5], val[6][e4] * s1[6], val[7][e4] * s1[7]});
                        *(u32x4*)(PKDT + (size_t)ci * RS + (ch0 + e4) * 64 + tg * 8) = pack8((f32x4){val[0][e4] * s2[0], val[1][e4] * s2[1], val[2][e4] * s2[2], val[3][e4] * s2[3]}, (f32x4){val[4][e4] * s2[4], val[5][e4] * s2[5], val[6][e4] * s2[6], val[7][e4] * s2[7]});
                    }
                } else {
#pragma unroll
                    for (int e4 = 0; e4 < 4; ++e4)
                        *(u32x4*)(VBT + (ch0 + e4) * 72 + tg * 8) = pack8((f32x4){val[0][e4] * s1[0], val[1][e4] * s1[1], val[2][e4] * s1[2], val[3][e4] * s1[3]}, (f32x4){val[4][e4] * s1[4], val[5][e4] * s1[5], val[6][e4] * s1[6], val[7][e4] * s1[7]});
                }
            }
        }
        if (tid == 0) GL[ci] = expf(gcs[63]);
        lds_barrier();
#pragma unroll
        for (int s = 0; s < 2; ++s) {
            const int tt = w * 2 + s, ct = tt >> 2, jt = tt & 3;
            if (jt <= ct) {
                f32x4 kk = {0.f, 0.f, 0.f, 0.f}, qk = {0.f, 0.f, 0.f, 0.f};
#pragma unroll
                for (int ks = 0; ks < 4; ++ks) {
                    const bf16x8 kc = *(const bf16x8*)(Kt + (ct * 16 + fr) * 136 + ks * 32 + 8 * fq);
                    const bf16x8 kj = *(const bf16x8*)(Kt + (jt * 16 + fr) * 136 + ks * 32 + 8 * fq);
                    const bf16x8 qc = *(const bf16x8*)(Qt + (ct * 16 + fr) * 136 + ks * 32 + 8 * fq);
                    kk = MFMA16(kc, kj, kk);
                    qk = MFMA16(kj, qc, qk);
                }
                { const int j = jt * 16 + fr; const float gj = gcs[j];
#pragma unroll
                  for (int jj = 0; jj < 4; ++jj) { const int c = ct * 16 + 4 * fq + jj;
                      Mf[c * 68 + j] = (j < c) ? gcs[64 + c] * kk[jj] * expf(gcs[c] - gj) : 0.f; } }
                { const int c = ct * 16 + fr; const float gc = gcs[c]; float o4[4];
#pragma unroll
                  for (int jj = 0; jj < 4; ++jj) { const int j = jt * 16 + 4 * fq + jj; o4[jj] = (j <= c) ? qk[jj] * expf(gc - gcs[j]) : 0.f; }
                  u32x2 wv; wv.x = pk2(o4[0], o4[1]); wv.y = pk2(o4[2], o4[3]);
                  *(u32x2*)(PQK + (size_t)ci * RS + c * 64 + jt * 16 + 4 * fq) = wv; }
            } else {
                const int c = ct * 16 + fr;
                *(u32x2*)(PQK + (size_t)ci * RS + c * 64 + jt * 16 + 4 * fq) = (u32x2){0u, 0u};
            }
        }
        lds_barrier();
        if (w == 0) {
            int lz = 0; asm volatile("" : "+v"(lz));
            const float* Mfz = Mf + lz;
            float X[64];
#pragma unroll
            for (int i = 0; i < 64; ++i) {
                f32x4 mv[16];
#pragma unroll
                for (int q = 0; q < (i + 3) / 4; ++q) mv[q] = *(const f32x4*)(Mfz + i * 68 + 4 * q);
                float a0 = (lane == i) ? 1.f : 0.f, a1 = 0.f, a2 = 0.f, a3 = 0.f;
#pragma unroll
                for (int j = 0; j < i; ++j) { const float t = mv[j >> 2][j & 3] * X[j]; if ((j & 3) == 0) a0 -= t; else if ((j & 3) == 1) a1 -= t; else if ((j & 3) == 2) a2 -= t; else a3 -= t; }
                X[i] = (a0 + a1) + (a2 + a3);
            }
#pragma unroll
            for (int i = 0; i < 64; ++i) AI[i * 72 + lane] = f2bf(X[i]);
        }
        lds_barrier();
#pragma unroll
        for (int ct = 0; ct < 4; ++ct) {
            f32x4 u = {0.f, 0.f, 0.f, 0.f}, ww = {0.f, 0.f, 0.f, 0.f};
#pragma unroll
            for (int ks = 0; ks < 2; ++ks) {
                const bf16x8 ai = *(const bf16x8*)(AI + (ct * 16 + fr) * 72 + ks * 32 + 8 * fq);
                const bf16x8 vb = *(const bf16x8*)(VBT + (w * 16 + fr) * 72 + ks * 32 + 8 * fq);
                const bf16x8 kb = *(const bf16x8*)(KBGT + (w * 16 + fr) * 72 + ks * 32 + 8 * fq);
                u = MFMA16(ai, vb, u);
                ww = MFMA16(kb, ai, ww);
            }
            { u32x2 wv; wv.x = pk2(u[0], u[1]); wv.y = pk2(u[2], u[3]); *(u32x2*)(PUT + (size_t)ci * RS + (w * 16 + fr) * 64 + ct * 16 + 4 * fq) = wv; }
            { u32x2 wv; wv.x = pk2(ww[0], ww[1]); wv.y = pk2(ww[2], ww[3]); *(u32x2*)(PW + (size_t)ci * RS + (ct * 16 + fr) * 128 + w * 16 + 4 * fq) = wv; }
        }
        lds_barrier();
    }
}

struct ScanOps { bf16x8 A4[4], KDf[2], QKf[2]; u32x2 Uf[2]; float gl; };
DI void scan_reload_a(const P& p, ScanOps& B, int ci, int role, int mt, int fr, int fq) {
    const bf16_t* base = (const bf16_t*)(p.ws + (role ? O_PQD : O_PW)) + (size_t)ci * RS + (mt * 16 + fr) * 128 + 8 * fq;
#pragma unroll
    for (int ks = 0; ks < 4; ++ks) B.A4[ks] = *(const bf16x8*)(base + ks * 32);
}
DI void scan_reload_x(const P& p, ScanOps& B, int ci, int role, int mt, int fr, int fq, int dv0) {
    if (role) {
        const bf16_t* q = (const bf16_t*)(p.ws + O_PQK) + (size_t)ci * RS + (mt * 16 + fr) * 64 + 8 * fq;
        B.QKf[0] = *(const bf16x8*)q; B.QKf[1] = *(const bf16x8*)(q + 32);
    } else {
        const bf16_t* u = (const bf16_t*)(p.ws + O_PUT) + (size_t)ci * RS + (dv0 + fr) * 64 + mt * 16 + 4 * fq;
        B.Uf[0] = *(const u32x2*)u; B.Uf[1] = *(const u32x2*)(u + 16 * 64);
    }
}
DI void scan_reload_k(const P& p, ScanOps& B, int ci, int w, int fr, int fq) {
    const bf16_t* k = (const bf16_t*)(p.ws + O_PKDT) + (size_t)ci * RS + (w * 16 + fr) * 64 + 8 * fq;
    B.KDf[0] = *(const bf16x8*)k; B.KDf[1] = *(const bf16x8*)(k + 32);
    B.gl = ((const float*)(p.ws + O_GL))[ci];
}
DI void scan_step(const P& p, ScanOps& B, int ci_next, f32x4& s0, f32x4& s1, bf16_t* ST, bf16_t* VT, float* __restrict__ op, int role, int mt, int w, int fr, int fq, int dv0) {
    f32x4 a0 = {0.f, 0.f, 0.f, 0.f}, a1 = {0.f, 0.f, 0.f, 0.f};
#pragma unroll
    for (int ks = 0; ks < 4; ++ks) {
        const bf16x8 b0 = *(const bf16x8*)(ST + fr * 136 + ks * 32 + 8 * fq), b1 = *(const bf16x8*)(ST + (16 + fr) * 136 + ks * 32 + 8 * fq);
        a0 = MFMA16(B.A4[ks], b0, a0); a1 = MFMA16(B.A4[ks], b1, a1);
    }
    scan_reload_a(p, B, ci_next, role, mt, fr, fq);
    if (role == 0) {
        u32x2 w0, w1;
        w0.x = pk2(lo_f(B.Uf[0].x) - a0[0], hi_f(B.Uf[0].x) - a0[1]); w0.y = pk2(lo_f(B.Uf[0].y) - a0[2], hi_f(B.Uf[0].y) - a0[3]);
        w1.x = pk2(lo_f(B.Uf[1].x) - a1[0], hi_f(B.Uf[1].x) - a1[1]); w1.y = pk2(lo_f(B.Uf[1].y) - a1[2], hi_f(B.Uf[1].y) - a1[3]);
        *(u32x2*)(VT + fr * 72 + mt * 16 + 4 * fq) = w0; *(u32x2*)(VT + (16 + fr) * 72 + mt * 16 + 4 * fq) = w1;
        scan_reload_x(p, B, ci_next, 0, mt, fr, fq, dv0);
    }
    lds_barrier();
    const bf16x8 v00 = *(const bf16x8*)(VT + fr * 72 + 8 * fq), v01 = *(const bf16x8*)(VT + fr * 72 + 32 + 8 * fq);
    const bf16x8 v10 = *(const bf16x8*)(VT + (16 + fr) * 72 + 8 * fq), v11 = *(const bf16x8*)(VT + (16 + fr) * 72 + 32 + 8 * fq);
    if (role == 1) {
        a0 = MFMA16(B.QKf[0], v00, a0); a0 = MFMA16(B.QKf[1], v01, a0);
        a1 = MFMA16(B.QKf[0], v10, a1); a1 = MFMA16(B.QKf[1], v11, a1);
        scan_reload_x(p, B, ci_next, 1, mt, fr, fq, dv0);
#pragma unroll
        for (int jj = 0; jj < 4; ++jj) { op[(size_t)jj * 512] = a0[jj]; op[(size_t)jj * 512 + 16] = a1[jj]; }
    }
    s0 = s0 * B.gl; s1 = s1 * B.gl;
    s0 = MFMA16(B.KDf[0], v00, s0); s0 = MFMA16(B.KDf[1], v01, s0);
    s1 = MFMA16(B.KDf[0], v10, s1); s1 = MFMA16(B.KDf[1], v11, s1);
    scan_reload_k(p, B, ci_next, w, fr, fq);
    { u32x2 wv; wv.x = pk2(s0[0], s0[1]); wv.y = pk2(s0[2], s0[3]); *(u32x2*)(ST + fr * 136 + w * 16 + 4 * fq) = wv; }
    { u32x2 wv; wv.x = pk2(s1[0], s1[1]); wv.y = pk2(s1[2], s1[3]); *(u32x2*)(ST + (16 + fr) * 136 + w * 16 + 4 * fq) = wv; }
    lds_barrier();
}
DI void ph_dn_scan(const P& p, unsigned char* lds_, float* __restrict__ OB) {
    bf16_t* ST = (bf16_t*)lds_;
    bf16_t* VT = ST + 32 * 136;
    const int tid = tidx(), lane = tid & 63, w = __builtin_amdgcn_readfirstlane(tid >> 6), fr = lane & 15, fq = lane >> 4, mt = w >> 1, role = w & 1;
    const int vb = (gridDim.x >= 128) ? (int)(blockIdx.x & 7) * 16 + (int)(blockIdx.x >> 3) : (int)blockIdx.x;
    for (int chain = vb; chain < 128; chain += gridDim.x) {
        const int bh = chain >> 2, dv0 = (chain & 3) * 32, b = bh >> 2, h = bh & 3, c0 = bh * 64;
        f32x4 s0 = {0.f, 0.f, 0.f, 0.f}, s1 = {0.f, 0.f, 0.f, 0.f};
        *(u32x2*)(ST + fr * 136 + w * 16 + 4 * fq) = (u32x2){0u, 0u}; *(u32x2*)(ST + (16 + fr) * 136 + w * 16 + 4 * fq) = (u32x2){0u, 0u};
        float* op = OB + ((size_t)b * S_ + mt * 16 + 4 * fq) * 512 + h * 128 + dv0 + fr;
        ScanOps A, Bf, C;
        scan_reload_a(p, A, c0, role, mt, fr, fq); scan_reload_x(p, A, c0, role, mt, fr, fq, dv0); scan_reload_k(p, A, c0, w, fr, fq);
        scan_reload_a(p, Bf, c0 + 1, role, mt, fr, fq); scan_reload_x(p, Bf, c0 + 1, role, mt, fr, fq, dv0); scan_reload_k(p, Bf, c0 + 1, w, fr, fq);
        scan_reload_a(p, C, c0 + 2, role, mt, fr, fq); scan_reload_x(p, C, c0 + 2, role, mt, fr, fq, dv0); scan_reload_k(p, C, c0 + 2, w, fr, fq);
        lds_barrier();
        for (int n = 0; n < 63; n += 3) {
            scan_step(p, A, c0 + (n + 3 < 64 ? n + 3 : 63), s0, s1, ST, VT, op + (size_t)n * 64 * 512, role, mt, w, fr, fq, dv0);
            scan_step(p, Bf, c0 + (n + 4 < 64 ? n + 4 : 63), s0, s1, ST, VT, op + (size_t)(n + 1) * 64 * 512, role, mt, w, fr, fq, dv0);
            scan_step(p, C, c0 + (n + 5 < 64 ? n + 5 : 63), s0, s1, ST, VT, op + (size_t)(n + 2) * 64 * 512, role, mt, w, fr, fq, dv0);
        }
        scan_step(p, A, c0 + 63, s0, s1, ST, VT, op + (size_t)63 * 64 * 512, role, mt, w, fr, fq, dv0);
    }
}

struct AttnRegs { u32x4 kr[4], vr[4]; bf16x8 qf[2]; };
DI void attn_decode(int it, int& g, int& b, int& h, int& r, int& l0, int& d) {
    g = it >> 10; const int rem = it & 1023; b = rem >> 7; h = (rem >> 5) & 3; const int x = rem & 31;
    d = g == 0 ? 1 : (g == 1 ? 4 : 16); const int sh = g * 2; r = x & (d - 1); l0 = (x >> sh) * 128;
}
DI void attn_load(const bf16_t* __restrict__ QKV, int it, int tid, AttnRegs& R) {
    int g, b, h, r, l0, d; attn_decode(it, g, b, h, r, l0, d);
    const int lane = tid & 63, w = tid >> 6, fr = lane & 15, fq = lane >> 4;
#pragma unroll
    for (int i = 0; i < 4; ++i) {
        const int c = tid + 512 * i, key = c >> 3, part = c & 7, sl = l0 - 128 + key;
        if (sl >= 0) { const bf16_t* kp = QKV + ((size_t)b * S_ + (size_t)sl * d + r) * 2304 + 768 + g * 256 + h * 64 + part * 8;
            R.kr[i] = *(const u32x4*)kp; R.vr[i] = *(const u32x4*)(kp + 768); }
        else { R.kr[i] = (u32x4){0u, 0u, 0u, 0u}; R.vr[i] = (u32x4){0u, 0u, 0u, 0u}; }
    }
    const bf16_t* qp = QKV + ((size_t)b * S_ + (size_t)(l0 + 16 * w + fr) * d + r) * 2304 + g * 256 + h * 64 + 8 * fq;
    R.qf[0] = *(const bf16x8*)qp; R.qf[1] = *(const bf16x8*)(qp + 32);
}
DI void ph_attn(const P& p, unsigned char* lds_) {
    bf16_t* Ks = (bf16_t*)lds_;
    bf16_t* VT = Ks + 256 * 72;
    const bf16_t* QKV = (const bf16_t*)(p.ws + O_QKV); bf16_t* OG = (bf16_t*)((unsigned char*)p.out + 64 * MiB); float* LSE = (float*)((unsigned char*)p.out + 112 * MiB);
    AttnRegs R;
    const int vblk = (gridDim.x % 8u == 0u) ? (int)(blockIdx.x & 7) * (int)(gridDim.x >> 3) + (int)(blockIdx.x >> 3) : (int)blockIdx.x;
    if (vblk < 3072) attn_load(QKV, vblk, tidx(), R);
    for (int it = vblk; it < 3072; it += gridDim.x) {
        const int tid = tidx(), lane = tid & 63, w = __builtin_amdgcn_readfirstlane(tid >> 6), fr = lane & 15, fq = lane >> 4;
        int g, b, h, r, l0, d; attn_decode(it, g, b, h, r, l0, d);
#pragma unroll
        for (int i = 0; i < 4; ++i) {
            const int c = tid + 512 * i, key = c >> 3, part = c & 7;
            *(u32x4*)(Ks + key * 72 + part * 8) = R.kr[i];
            const unsigned vv[4] = {R.vr[i].x, R.vr[i].y, R.vr[i].z, R.vr[i].w};
#pragma unroll
            for (int e = 0; e < 4; ++e) { VT[(part * 8 + 2 * e) * 264 + key] = (bf16_t)(vv[e] & 0xffffu); VT[(part * 8 + 2 * e + 1) * 264 + key] = (bf16_t)(vv[e] >> 16); }
        }
        const bf16x8 qf0 = R.qf[0], qf1 = R.qf[1];
        lds_barrier();
        if (it + (int)gridDim.x < 3072) attn_load(QKV, it + gridDim.x, tid, R);
        const int qt = w, qi = 16 * qt + fr;
        f32x4 st[9];
#pragma unroll
        for (int jt = 0; jt < 9; ++jt) {
            const bf16_t* kp = Ks + (16 * (qt + jt) + fr) * 72 + 8 * fq;
            f32x4 a = {0.f, 0.f, 0.f, 0.f};
            a = MFMA16(*(const bf16x8*)kp, qf0, a);
            a = MFMA16(*(const bf16x8*)(kp + 32), qf1, a);
            st[jt] = a;
        }
        float m = -1e30f;
#pragma unroll
        for (int jt = 0; jt < 9; ++jt)
#pragma unroll
            for (int jj = 0; jj < 4; ++jj) {
                const int j = 16 * (qt + jt) + 4 * fq + jj;
                const bool valid = (j >= qi) && (j <= 128 + qi) && (l0 - 128 + j >= 0);
                const float s = valid ? st[jt][jj] * (0.125f * 1.44269504089f) : -1e30f;
                st[jt][jj] = s; m = fmaxf(m, s);
            }
        m = fmaxf(m, __shfl_xor(m, 16)); m = fmaxf(m, __shfl_xor(m, 32));
        float den = 0.f;
#pragma unroll
        for (int jt = 0; jt < 9; ++jt)
#pragma unroll
            for (int jj = 0; jj < 4; ++jj) { const float e = __builtin_amdgcn_exp2f(st[jt][jj] - m); st[jt][jj] = e; den += e; }
        den += __shfl_xor(den, 16); den += __shfl_xor(den, 32);
        f32x4 o[4];
#pragma unroll
        for (int dt = 0; dt < 4; ++dt) o[dt] = (f32x4){0.f, 0.f, 0.f, 0.f};
#pragma unroll
        for (int a = 0; a < 5; ++a) {
            u32x4 pw; pw.x = pk2(st[2 * a][0], st[2 * a][1]); pw.y = pk2(st[2 * a][2], st[2 * a][3]);
            if (a < 4) { pw.z = pk2(st[2 * a + 1][0], st[2 * a + 1][1]); pw.w = pk2(st[2 * a + 1][2], st[2 * a + 1][3]); } else { pw.z = 0u; pw.w = 0u; }
            const bf16x8 pf = __builtin_bit_cast(bf16x8, pw);
            const int kA = 16 * (qt + 2 * a) + 4 * fq, kB = a < 4 ? kA + 16 : kA;
#pragma unroll
            for (int dt = 0; dt < 4; ++dt) {
                const bf16_t* vp = VT + (dt * 16 + fr) * 264;
                const u32x2 va = *(const u32x2*)(vp + kA), vb = *(const u32x2*)(vp + kB);
                const bf16x8 vf = __builtin_bit_cast(bf16x8, ((u32x4){va.x, va.y, vb.x, vb.y}));
                o[dt] = MFMA16(vf, pf, o[dt]);
            }
        }
        const size_t row = (size_t)b * S_ + (size_t)(l0 + qi) * d + r;
        const float inv = 1.f / den;
        bf16_t* op = OG + ((size_t)g * T_ + row) * 256 + h * 64 + 4 * fq;
#pragma unroll
        for (int dt = 0; dt < 4; ++dt) { u32x2 wv; wv.x = pk2(o[dt][0] * inv, o[dt][1] * inv); wv.y = pk2(o[dt][2] * inv, o[dt][3] * inv); *(u32x2*)(op + dt * 16) = wv; }
        if (fq == 0) LSE[((size_t)g * T_ + row) * 4 + h] = (m + log2f(den)) * 0.69314718056f;
        lds_barrier();
    }
}

DI void ph_merge_oa(const P& p, int bid, int nblk) {
    const int lane = tidx() & 63, wave = tidx() >> 6;
    const bf16_t* OG = (const bf16_t*)((unsigned char*)p.out + 64 * MiB); const float* LSE = (const float*)((unsigned char*)p.out + 112 * MiB);
    bf16_t* OA = (bf16_t*)(p.ws + O_OA);
    const int hh = lane >> 4;
    for (int t = bid * 8 + wave; t < T_; t += nblk * 8) {
        float ls[3], mx = -1e30f;
#pragma unroll
        for (int g = 0; g < 3; ++g) { ls[g] = LSE[((size_t)g * T_ + t) * 4 + hh]; mx = fmaxf(mx, ls[g]); }
        float e[3], se = 0.f;
#pragma unroll
        for (int g = 0; g < 3; ++g) { e[g] = expf(ls[g] - mx); se += e[g]; }
        float a0 = 0.f, a1 = 0.f, a2 = 0.f, a3 = 0.f;
#pragma unroll
        for (int g = 0; g < 3; ++g) { const u32x2 v = *(const u32x2*)(OG + ((size_t)g * T_ + t) * 256 + 4 * lane); const float al = e[g] / se;
            a0 += al * lo_f(v.x); a1 += al * hi_f(v.x); a2 += al * lo_f(v.y); a3 += al * hi_f(v.y); }
        { u32x2 w; w.x = pk2(a0, a1); w.y = pk2(a2, a3); *(u32x2*)(OA + (size_t)t * 256 + 4 * lane) = w; }
    }
}
DI void ph_merge(const P& p, int l, const float* __restrict__ OB) {
    const int lane = tidx() & 63, wave = tidx() >> 6;
    const bf16_t* DZ = (const bf16_t*)(p.ws + O_DZ);
    bf16_t* OBN = (bf16_t*)(p.ws + O_OBN);
    const float* onw = p.dn_onorm_w + l * 128;
    for (int t = blockIdx.x * 8 + wave; t < T_; t += gridDim.x * 8) {
        const f32x4* ob = (const f32x4*)(OB + (size_t)t * 512 + 8 * lane);
        const f32x4 b0 = ob[0], b1 = ob[1];
        float ss = b0.x * b0.x + b0.y * b0.y + b0.z * b0.z + b0.w * b0.w + b1.x * b1.x + b1.y * b1.y + b1.z * b1.z + b1.w * b1.w;
#pragma unroll
        for (int o = 1; o < 16; o <<= 1) ss += __shfl_xor(ss, o);
        const float r = 1.f / sqrtf(ss * (1.f / 128.f) + 1e-6f);
        float z[8]; unpack8(*(const u32x4*)(DZ + (size_t)t * 512 + 8 * lane), z);
        const f32x4 w0 = *(const f32x4*)(onw + ((8 * lane) & 127)), w1 = *(const f32x4*)(onw + ((8 * lane) & 127) + 4);
        f32x4 y0, y1;
#pragma unroll
        for (int i = 0; i < 4; ++i) { y0[i] = b0[i] * r * w0[i] * fsilu(z[i]); y1[i] = b1[i] * r * w1[i] * fsilu(z[4 + i]); }
        *(u32x4*)(OBN + (size_t)t * 512 + 8 * lane) = pack8(y0, y1);
    }
}

DI void ph_convglu(const P& p, int l, int half) {
    const bf16_t* U = (const bf16_t*)(p.ws + O_UPH); bf16_t* ACT = (bf16_t*)(p.ws + O_ACT);
    const float* cw = p.ffn_conv_w + (size_t)l * 3 * NUP; const float* cb = p.ffn_conv_b + (size_t)l * NUP;
    const int HT = T_ / 2, NC8 = DFF / 8, RB = 16;
    for (int it = blockIdx.x * NT + tidx(); it < (HT / RB) * NC8; it += gridDim.x * NT) {
        const int rb = it / NC8, c = (it % NC8) * 8, row0 = rb * RB;
        float wg[3][8], wv[3][8], bg[8], bv[8];
#pragma unroll
        for (int j = 0; j < 3; ++j) { const f32x4 a = *(const f32x4*)(cw + j * NUP + c), b = *(const f32x4*)(cw + j * NUP + c + 4), cc = *(const f32x4*)(cw + j * NUP + DFF + c), d = *(const f32x4*)(cw + j * NUP + DFF + c + 4);
#pragma unroll
            for (int e = 0; e < 4; ++e) { wg[j][e] = a[e]; wg[j][4 + e] = b[e]; wv[j][e] = cc[e]; wv[j][4 + e] = d[e]; } }
        { const f32x4 a = *(const f32x4*)(cb + c), b = *(const f32x4*)(cb + c + 4), cc = *(const f32x4*)(cb + DFF + c), d = *(const f32x4*)(cb + DFF + c + 4);
#pragma unroll
          for (int e = 0; e < 4; ++e) { bg[e] = a[e]; bg[4 + e] = b[e]; bv[e] = cc[e]; bv[4 + e] = d[e]; } }
        u32x4 g2 = {0u, 0u, 0u, 0u}, g1 = g2, v2 = g2, v1 = g2;
        if ((row0 % S_) != 0) { const bf16_t* up = U + (size_t)(row0 - 2) * NUP + c; g2 = *(const u32x4*)up; v2 = *(const u32x4*)(up + DFF); g1 = *(const u32x4*)(up + NUP); v1 = *(const u32x4*)(up + NUP + DFF); }
#pragma unroll 4
        for (int i = 0; i < RB; ++i) {
            const bf16_t* up = U + (size_t)(row0 + i) * NUP + c;
            const u32x4 g0 = *(const u32x4*)up, v0 = *(const u32x4*)(up + DFF);
            float a2[8], a1[8], a0[8], b2[8], b1[8], b0[8];
            unpack8(g2, a2); unpack8(g1, a1); unpack8(g0, a0); unpack8(v2, b2); unpack8(v1, b1); unpack8(v0, b0);
            float y[8];
#pragma unroll
            for (int e = 0; e < 8; ++e) {
                const float gs = bg[e] + wg[0][e] * a2[e] + wg[1][e] * a1[e] + wg[2][e] * a0[e];
                const float vs = bv[e] + wv[0][e] * b2[e] + wv[1][e] * b1[e] + wv[2][e] * b0[e];
                y[e] = fsilu(gs) * vs;
            }
            *(u32x4*)(ACT + (size_t)(half * HT + row0 + i) * DFF + c) = pack8((f32x4){y[0], y[1], y[2], y[3]}, (f32x4){y[4], y[5], y[6], y[7]});
            g2 = g1; g1 = g0; v2 = v1; v1 = v0;
        }
    }
}


constexpr size_t O_HEAD = O_ACT + 176 * MiB, O_TAIL = O_HEAD + 22 * MiB;
template <int CTRL> DI float dppf(float x) { return __builtin_bit_cast(float, __builtin_amdgcn_update_dpp(0, __builtin_bit_cast(int, x), CTRL, 0xf, 0xf, true)); }
struct EpiConvGlu {
    static constexpr bool PERM = true, AFTER_DRAIN = false;
    bf16_t* ACT; float* HEAD; float* TAIL; const float* cw; const float* cb;
    DI void operator()(const pg8::f32x4 (&acc)[2][2][4][2], const pg8::Unit& u, int wr, int wc, int fr, int fq) const {
        const int chb = 128 * u.pn + 32 * wc + 8 * fq;
#pragma unroll
        for (int n = 0; n < 2; ++n) {
            const unsigned ch = (unsigned)(chb + 4 * n), cq = ch >> 2;
            const f32x4* __restrict__ W0 = (const f32x4*)cw; const f32x4* __restrict__ W1 = (const f32x4*)(cw + NUP); const f32x4* __restrict__ W2 = (const f32x4*)(cw + 2 * NUP); const f32x4* __restrict__ WB = (const f32x4*)cb;
            const f32x4 g0 = W0[cq], g1 = W1[cq], g2 = W2[cq], gb = WB[cq];
            const f32x4 v0 = W0[cq + DFF / 4], v1 = W1[cq + DFF / 4], v2 = W2[cq + DFF / 4], vb = WB[cq + DFF / 4];
            asm volatile("" ::: "memory"); __builtin_amdgcn_sched_barrier(0);
#pragma unroll
            for (int ai = 0; ai < 2; ++ai) {
                const int grp = 4 * u.pm + 2 * ai + wr;
                f32x4 act[4], hg, hv; float chain = 0.f;
#pragma unroll
                for (int e = 0; e < 4; ++e) {
                    float pg15 = 0.f, pg14 = 0.f, pv15 = 0.f, pv14 = 0.f;
#pragma unroll
                    for (int m = 0; m < 4; ++m) {
                        float xg = acc[ai][0][m][n][e], xv = acc[ai][1][m][n][e];
                        asm volatile("" : "+v"(xg), "+v"(xv) : "v"(chain));
                        const float g_1 = dppf<0x111>(xg) + pg15, g_2 = dppf<0x112>(xg) + pg14;
                        const float v_1 = dppf<0x111>(xv) + pv15, v_2 = dppf<0x112>(xv) + pv14;
                        const float yg = gb[e] + g0[e] * g_2 + g1[e] * g_1 + g2[e] * xg;
                        const float yv = vb[e] + v0[e] * v_2 + v1[e] * v_1 + v2[e] * xv;
                        if (m == 0) { hg[e] = yg; hv[e] = yv; }
                        act[m][e] = fsilu(yg) * yv; chain = act[m][e];
                        if (m < 3) { pg15 = dppf<0x10F>(xg); pg14 = dppf<0x10E>(xg); pv15 = dppf<0x10F>(xv); pv14 = dppf<0x10E>(xv); }
                    }
                    __builtin_amdgcn_sched_barrier(0);
                }
                if (fr < 2) { const unsigned ho = ((unsigned)(grp * 2 + fr) * NUP + ch) * 4u; *(f32x4*)((char*)HEAD + ho) = hg; *(f32x4*)((char*)HEAD + ho + DFF * 4u) = hv; }
#pragma unroll
                for (int m = 0; m < 4; ++m) {
                    if (!(m == 0 && fr < 2)) {
                        u32x2 wv; wv.x = pk2(act[m][0], act[m][1]); wv.y = pk2(act[m][2], act[m][3]);
                        const unsigned ao = ((unsigned)(grp * 64 + 16 * m + fr) * DFF + ch) * 2u;
                        *(u32x2*)((char*)ACT + ao) = wv;
                    }
                }
                if (fr >= 14) { const unsigned to = ((unsigned)(grp * 2 + (fr - 14)) * NUP + ch) * 4u; *(f32x4*)((char*)TAIL + to) = acc[ai][0][3][n]; *(f32x4*)((char*)TAIL + to + DFF * 4u) = acc[ai][1][3][n]; }
                asm volatile("" ::: "memory"); __builtin_amdgcn_sched_barrier(0);
            }
        }
    }
};
DI void ph_ffn_fix(const P& p, int l) {
    bf16_t* ACT = (bf16_t*)(p.ws + O_ACT); const float* HEAD = (const float*)(p.ws + O_HEAD); const float* TAIL = (const float*)(p.ws + O_TAIL);
    const float* cw = p.ffn_conv_w + (size_t)l * 3 * NUP;
    for (int it = blockIdx.x * NT + tidx(); it < 512 * (DFF / 4); it += gridDim.x * NT) {
        const int g = it / (DFF / 4), ch = (it % (DFF / 4)) * 4;
        const bool first = (g & 63) == 0;
        const float* hp = HEAD + (size_t)g * 2 * NUP + ch;
        f32x4 yg0 = *(const f32x4*)hp, yv0 = *(const f32x4*)(hp + DFF), yg1 = *(const f32x4*)(hp + NUP), yv1 = *(const f32x4*)(hp + NUP + DFF);
        if (!first) {
            const float* tp = TAIL + (size_t)(g - 1) * 2 * NUP + ch;
            const f32x4 tg0 = *(const f32x4*)tp, tv0 = *(const f32x4*)(tp + DFF), tg1 = *(const f32x4*)(tp + NUP), tv1 = *(const f32x4*)(tp + NUP + DFF);
            const f32x4 w0g = *(const f32x4*)(cw + ch), w1g = *(const f32x4*)(cw + NUP + ch), w0v = *(const f32x4*)(cw + DFF + ch), w1v = *(const f32x4*)(cw + NUP + DFF + ch);
            yg0 = yg0 + w1g * tg1 + w0g * tg0; yv0 = yv0 + w1v * tv1 + w0v * tv0;
            yg1 = yg1 + w0g * tg1; yv1 = yv1 + w0v * tv1;
        }
        u32x2 a, b;
        a.x = pk2(fsilu(yg0[0]) * yv0[0], fsilu(yg0[1]) * yv0[1]); a.y = pk2(fsilu(yg0[2]) * yv0[2], fsilu(yg0[3]) * yv0[3]);
        b.x = pk2(fsilu(yg1[0]) * yv1[0], fsilu(yg1[1]) * yv1[1]); b.y = pk2(fsilu(yg1[2]) * yv1[2], fsilu(yg1[3]) * yv1[3]);
        *(u32x2*)(ACT + (size_t)g * 64 * DFF + ch) = a; *(u32x2*)(ACT + ((size_t)g * 64 + 1) * DFF + ch) = b;
    }
}
template <class E> DI void gemm_fast_epi(unsigned char* lds, const bf16_t* A, const bf16_t* WT, int M, int N, int K, const E& e) {
    asm volatile("" : "+s"(K));
    pg8::Gemm g{A, WT, M, N, K}; pg8::StaticOrder S; S.init(M, N, (int)gridDim.x, (int)blockIdx.x);
    pg8::gemm_phase((PG8_LAS unsigned char*)lds, g, S, e);
}

constexpr size_t O_RBF = O_QKV;
DI void ph_final(const P& p) {
    const int lane = tidx() & 63, wave = tidx() >> 6;
    const bf16_t* RB = (const bf16_t*)(p.ws + O_RBF);
    for (int row = blockIdx.x * 8 + wave; row < T_; row += gridDim.x * 8) {
        const u32x2* xb = (const u32x2*)(RB + (size_t)row * DM) + lane;
        f32x4* xr = (f32x4*)(p.out + (size_t)row * DM) + lane;
        f32x4 v[4]; float ss = 0.f;
#pragma unroll
        for (int j = 0; j < 4; ++j) { const u32x2 q = xb[64 * j]; v[j] = (f32x4){lo_f(q.x), hi_f(q.x), lo_f(q.y), hi_f(q.y)}; ss += v[j].x * v[j].x + v[j].y * v[j].y + v[j].z * v[j].z + v[j].w * v[j].w; }
        ss = wave_sum(ss);
        const float r = 1.f / sqrtf(ss * (1.f / DM) + 1e-6f);
#pragma unroll
        for (int j = 0; j < 4; ++j) { const f32x4 ww = ((const f32x4*)p.final_norm_w)[lane + 64 * j]; xr[64 * j] = v[j] * r * ww; }
    }
}

#define XB_TMO      128
#define XB_XCNT(j)  (256  + 64 * (j))
#define XB_XSUB(j)  (1280 + 64 * (j))
#define XB_XGEN(j)  (2304 + 64 * (j))
#define XB_TOP      3328
#define XB_TOPGEN   3392
#define XCD_BAR_WORDS 3456
#define XB_SPIN_CAP (1u << 18)
#define LAS __attribute__((address_space(3)))

__device__ __forceinline__ unsigned xb_ld(unsigned* p)              { return __hip_atomic_load(p, __ATOMIC_RELAXED, __HIP_MEMORY_SCOPE_AGENT); }
__device__ __forceinline__ unsigned xb_add(unsigned* p, unsigned v) { return __hip_atomic_fetch_add(p, v, __ATOMIC_RELAXED, __HIP_MEMORY_SCOPE_AGENT); }
__device__ __forceinline__ unsigned xb_xcc_id() { return (unsigned)__builtin_amdgcn_s_getreg((3 << 11) | 20) & 0xFu; }
#define XB_SPIN(cond, bar) do { unsigned _sp = 0; while (cond) { __builtin_amdgcn_s_sleep(1); \
    if ((++_sp & 255u) == 0u) { if (xb_ld(&(bar)[XB_TMO])) break; if (_sp > XB_SPIN_CAP) { atomicAdd(&(bar)[XB_TMO], 1u); break; } } } } while (0)

struct XcdBarrier {
    unsigned* bar; unsigned x;
    volatile LAS unsigned* st;
};

__device__ __forceinline__ XcdBarrier xcd_barrier_post(unsigned* bar, volatile LAS unsigned* st) {
    XcdBarrier b; b.bar = bar; b.x = xb_xcc_id(); b.st = st;
    if (threadIdx.x == 0) (void)xb_add(&bar[XB_XCNT(b.x)], 1u);
    return b;
}
__device__ __forceinline__ void xcd_barrier_complete(unsigned* bar, unsigned x, unsigned& nloc, unsigned& nx) {
    const unsigned G = gridDim.x * gridDim.y * gridDim.z;
    unsigned sum, cnt, mine, sp = 0u;
    for (;;) {
        sum = 0u; cnt = 0u; mine = 0u;
#pragma unroll
        for (unsigned j = 0; j < 16; ++j) { const unsigned c = xb_ld(&bar[XB_XCNT(j)]); sum += c; cnt += (c > 0u) ? 1u : 0u; mine = (j == x) ? c : mine; }
        if (sum == G) break;
        __builtin_amdgcn_s_sleep(1);
        if ((++sp & 255u) == 0u) { if (xb_ld(&bar[XB_TMO])) break; if (sp > XB_SPIN_CAP) { atomicAdd(&bar[XB_TMO], 1u); break; } }
    }
    nloc = mine > 0u ? mine : 1u; nx = cnt > 0u ? cnt : 1u;
}

__device__ __forceinline__ void xcd_barrier(const XcdBarrier& b) {
    asm volatile("s_waitcnt vmcnt(0)" ::: "memory");
    __syncthreads();
    if (threadIdx.x == 0) {
        unsigned* bar = b.bar;
        __builtin_amdgcn_s_waitcnt(0);
        unsigned nloc = b.st[0], nx = b.st[1];
        if (nloc == 0u) { xcd_barrier_complete(bar, b.x, nloc, nx); b.st[0] = nloc; b.st[1] = nx; }
        const unsigned old = xb_add(&bar[XB_XSUB(b.x)], 1u);
        const unsigned gen = old / nloc;
        if (old + 1u == (gen + 1u) * nloc) {
            __builtin_amdgcn_fence(__ATOMIC_RELEASE, "agent");
            asm volatile("s_waitcnt vmcnt(0)" ::: "memory");
            const unsigned og = xb_add(&bar[XB_TOP], 1u);
            const unsigned tg = og / nx;
            if (og + 1u == (tg + 1u) * nx) xb_add(&bar[XB_TOPGEN], 1u);
            else XB_SPIN(xb_ld(&bar[XB_TOPGEN]) == tg, bar);
            __builtin_amdgcn_fence(__ATOMIC_ACQUIRE, "agent");
            xb_add(&bar[XB_XGEN(b.x)], 1u);
            asm volatile("s_waitcnt vmcnt(0)" ::: "memory");
        } else {
            XB_SPIN(xb_ld(&bar[XB_XGEN(b.x)]) == gen, bar);
            __builtin_amdgcn_fence(__ATOMIC_ACQUIRE, "agent");
            asm volatile("s_waitcnt vmcnt(0)" ::: "memory");
        }
    }
    __syncthreads();
}

template <class F> DI void gemm_fast_sub(unsigned char* lds, const bf16_t* A, const bf16_t* WT, int M, int N, int K, const F& f, int G, int c) {
    asm volatile("" : "+s"(K));
    pg8::Gemm g{A, WT, M, N, K}; pg8::StaticOrder S; S.init(M, N, G, c);
    EpiAdapt<F> E{f};
    pg8::gemm_phase((PG8_LAS unsigned char*)lds, g, S, E);
}
#ifndef XSYNC
#define XSYNC 0
#endif
#ifndef DUPMASK
#define DUPMASK 0
#endif
#ifndef FAST_DN
#define FAST_DN 1
#endif
#ifndef FAST_ATTN
#define FAST_ATTN 1
#endif
constexpr int STEPS_PER_LAYER = 12, NSTEPS = 2 * STEPS_PER_LAYER + 1;
DI void run_step(const P& p, int step, unsigned char* lds) {
    bf16_t* WB = (bf16_t*)(p.ws + O_W);
    if (step == NSTEPS - 1) { ph_final(p); return; }
    const int l = step / STEPS_PER_LAYER, s = step % STEPS_PER_LAYER;
    bf16_t* RB = (bf16_t*)p.out;
    float* OBp = (float*)(p.ws + (FAST_DN ? O_DQKV : O_OBN_NAIVE));
    switch (s) {
    case 0: ph_convert(p, l, lds, 0, gridDim.x == 256 ? CVT_EARLY : CVT_TOTAL, (int)blockIdx.x, (int)gridDim.x); if (l == 0) ph_rmsnorm<false>(p, p.x, p.norm1_w + l * DM, l, lds); else ph_rmsnorm<true>(p, RB, p.norm1_w + l * DM, l, lds); break;
    case 1: { EpiIn e{(bf16_t*)(p.ws + O_QKV), (bf16_t*)(p.ws + O_DQKV), (bf16_t*)(p.ws + O_DZ), (bf16_t*)(p.ws + O_SG), 0};
              GEMM((const bf16_t*)(p.ws + O_XN), WB + W_IN, T_, gridDim.x == 256 ? NIN - 256 : NIN, 1024, e); } break;
#if FAST_ATTN
    case 2: ph_attn(p, lds); break;
#else
    case 2: ph_attn_naive(p); break;
#endif
#if FAST_DN
    case 3: ph_dn_prep(p, l, lds); break;
    case 4: if (gridDim.x > 128) { if (blockIdx.x < 128) ph_dn_scan(p, lds, OBp);
                else { ph_merge_oa(p, (int)blockIdx.x - 128, (int)gridDim.x - 128);
                    if (gridDim.x == 256) { EpiIn e{(bf16_t*)(p.ws + O_QKV), (bf16_t*)(p.ws + O_DQKV), (bf16_t*)(p.ws + O_DZ), (bf16_t*)(p.ws + O_SG), NIN - 256};
                        gemm_fast_sub(lds, (const bf16_t*)(p.ws + O_XN), WB + W_IN + (size_t)(NIN - 256) * 1024, T_, 256, 1024, e, 128, (int)blockIdx.x - 128);
                        ph_convert(p, l, lds, CVT_EARLY, CVT_TOTAL, (int)blockIdx.x - 128, 128); } } }
            else { ph_dn_scan(p, lds, OBp); ph_merge_oa(p, (int)blockIdx.x, (int)gridDim.x); } break;
#else
    case 3: ph_dn_naive(p, l, lds, OBp); break;
    case 4: break;
#endif
    case 5: ph_merge(p, l, OBp); break;
    case 6: { EpiGate<0> e0{(bf16_t*)(p.ws + O_Y), (const bf16_t*)(p.ws + O_SG), 0};
              GEMM((const bf16_t*)(p.ws + O_OA), WB + W_PA, T_, 1024, 256, e0);
              EpiGate<1> e1{(bf16_t*)(p.ws + O_Y), (const bf16_t*)(p.ws + O_SG), 1024};
              GEMM((const bf16_t*)(p.ws + O_OBN), WB + W_PB, T_, 1024, 512, e1); } break;
    case 7: if (l == 0) { EpiResB<true> e{p.x, RB}; GEMM((const bf16_t*)(p.ws + O_Y), WB + W_O, T_, 1024, 1024, e); }
            else { EpiResB<false> e{RB, RB}; GEMM((const bf16_t*)(p.ws + O_Y), WB + W_O, T_, 1024, 1024, e); } break;
    case 8: ph_rmsnorm<true>(p, RB, p.norm2_w + l * DM, -1, lds); break;
    case 9: { EpiConvGlu e{(bf16_t*)(p.ws + O_ACT), (float*)(p.ws + O_HEAD), (float*)(p.ws + O_TAIL), p.ffn_conv_w + (size_t)l * 3 * NUP, p.ffn_conv_b + (size_t)l * NUP};
              gemm_fast_epi(lds, (const bf16_t*)(p.ws + O_XN), WB + W_UP, T_, NUP, 1024, e); } break;
    case 10: ph_ffn_fix(p, l); break;
    case 11: { EpiResB<false> e{RB, l == 1 ? (bf16_t*)(p.ws + O_RBF) : RB}; GEMM((const bf16_t*)(p.ws + O_ACT), WB + W_DN, T_, 1024, DFF, e); } break;
    }
}

__global__ void __launch_bounds__(NT, 2) k_step(P p, int step) {
    extern __shared__ __attribute__((aligned(16))) unsigned char lds[];
    run_step(p, step, lds);
}
#if MODE_COOP
__global__ void __launch_bounds__(NT, 2) k_mega(P p) {
    extern __shared__ __attribute__((aligned(16))) unsigned char lds[];
    cg::grid_group grid = cg::this_grid();
    volatile LAS unsigned* stw = (volatile LAS unsigned*)((LAS unsigned char*)lds + 131072);
    if (threadIdx.x < 4) stw[threadIdx.x] = 0u;
    __syncthreads();
    const XcdBarrier xbar = xcd_barrier_post((unsigned*)(p.ws + O_BAR), stw);
#pragma unroll 1
    for (int s = 0; s < NSTEPS; ++s) {
        run_step(p, s, lds);
#if DUPMASK
        if (s < NSTEPS - 1 && ((DUPMASK >> (s % STEPS_PER_LAYER)) & 1)) { grid.sync(); run_step(p, s, lds); }
#endif
        if (s + 1 < NSTEPS) { if (p.ws == nullptr) grid.sync(); else xcd_barrier(xbar); }
#if XSYNC
        if (s == 4) { for (int q = 0; q < XSYNC; ++q) grid.sync(); }
#endif
    }
}
#define K_MAIN k_mega
#else
#define K_MAIN k_step
#endif

extern "C" void kernel_launch(void* const* d_in, const int* in_sizes, int n_in, void* d_out, int out_size, void* d_ws, size_t ws_size, hipStream_t stream) {
    static int grid = 0;
    if (grid == 0) {
        if (n_in != 16 || out_size != T_ * DM || ws_size < O_END) { fprintf(stderr, "kernel_launch: unexpected shapes (n_in %d out %d ws %zu)\n", n_in, out_size, ws_size); grid = -1; return; }
        int dev = 0, cus = 0, per_cu = 0;
        (void)hipGetDevice(&dev);
        (void)hipDeviceGetAttribute(&cus, hipDeviceAttributeMultiprocessorCount, dev);
        if (cus <= 0) cus = 256;
        (void)hipFuncSetAttribute((const void*)K_MAIN, hipFuncAttributeMaxDynamicSharedMemorySize, LDS_BYTES);
        (void)hipOccupancyMaxActiveBlocksPerMultiprocessor(&per_cu, (const void*)K_MAIN, NT, LDS_BYTES);
        if (per_cu < 1) per_cu = 1;
        if (per_cu > 1) per_cu = 1;
        grid = cus * per_cu;
        (void)hipGetLastError();
    }
    if (grid < 0) return;
    P p{};
    const float** pp = (const float**)&p;
    for (int i = 0; i < 16; ++i) pp[i] = (const float*)d_in[i];
    p.out = (float*)d_out; p.ws = (unsigned char*)d_ws;
#if MODE_COOP
    (void)hipMemsetAsync((unsigned char*)d_ws + O_BAR, 0, XCD_BAR_WORDS * sizeof(unsigned), stream);
    void* args[] = {&p};
    hipError_t e = hipLaunchCooperativeKernel((const void*)k_mega, dim3(grid), dim3(NT), args, LDS_BYTES, stream);
    if (e != hipSuccess) fprintf(stderr, "cooperative launch failed: %s (grid %d)\n", hipGetErrorString(e), grid);
#else
    for (int s = 0; s < NSTEPS; ++s) hipLaunchKernelGGL(k_step, dim3(grid), dim3(NT), LDS_BYTES, stream, p, s);
#endif
}
```

```cpp
#include <hip/hip_runtime.h>
#include <hip/hip_cooperative_groups.h>
#include <cstdio>
namespace cg = cooperative_groups;

#ifndef MODE_COOP
#define MODE_COOP 1
#endif

#define DI __device__ __forceinline__
typedef unsigned short bf16_t;
typedef short bf16x8 __attribute__((ext_vector_type(8)));
typedef float f32x4 __attribute__((ext_vector_type(4)));
typedef unsigned u32x4 __attribute__((ext_vector_type(4)));
typedef unsigned u32x2 __attribute__((ext_vector_type(2)));

constexpr int T_ = 32768, S_ = 4096, DM = 1024, NIN = 6400, INW = 6408, DFF = 2816, NUP = 5632;
constexpr int NT = 512;
constexpr size_t MiB = (size_t)1 << 20;
constexpr size_t O_W = 0, O_XN = 33 * MiB, O_QKV = 97 * MiB, O_DQKV = 241 * MiB, O_DZ = 337 * MiB, O_SG = 369 * MiB, O_BG = 497 * MiB, O_GL = 498 * MiB, O_BAR = 499 * MiB, O_END = 500 * MiB;
constexpr size_t O_OG = O_XN, O_LSE = O_XN + 48 * MiB, O_Y = O_XN;
constexpr size_t O_OBN_NAIVE = O_QKV;
constexpr size_t O_OA = O_DQKV + 64 * MiB, O_OBN = O_QKV + 80 * MiB;
constexpr size_t O_UPH = O_QKV, O_ACT = O_QKV + 176 * MiB;
constexpr size_t W_IN = 0, W_PA = W_IN + (size_t)NIN * 1024, W_PB = W_PA + 1024 * 256, W_O = W_PB + 1024 * 512, W_UP = W_O + 1024 * 1024, W_DN = W_UP + (size_t)NUP * 1024;
constexpr int LDS_BYTES = 128 * 1024 + 1024;

struct P {
    const float *x, *norm1_w, *w_in, *dn_conv_w, *dn_a_log, *dn_dt_bias, *dn_onorm_w, *w_pa, *w_pb, *w_o, *norm2_w, *w_up, *ffn_conv_w, *ffn_conv_b, *w_down, *final_norm_w;
    float* out; unsigned char* ws;
};

DI int tidx() { int t = threadIdx.x; asm volatile("" : "+v"(t)); return t; }
DI void lds_barrier() { asm volatile("s_waitcnt lgkmcnt(0)" ::: "memory"); __builtin_amdgcn_s_barrier(); asm volatile("" ::: "memory"); }
DI bf16_t f2bf(float f) { unsigned u = __float_as_uint(f); u += 0x7fffu + ((u >> 16) & 1u); return (bf16_t)(u >> 16); }
DI float bf2f(bf16_t b) { return __uint_as_float(((unsigned)b) << 16); }
typedef float f32x2 __attribute__((ext_vector_type(2)));
typedef __bf16 bf16x2v __attribute__((ext_vector_type(2)));
DI unsigned pk2(float a, float b) { const f32x2 v = {a, b}; return __builtin_bit_cast(unsigned, __builtin_convertvector(v, bf16x2v)); }
DI float lo_f(unsigned u) { return __uint_as_float(u << 16); }
DI float hi_f(unsigned u) { return __uint_as_float(u & 0xffff0000u); }
DI float sigmoidf_(float x) { return 1.f / (1.f + expf(-x)); }
DI float siluf_(float x) { return x / (1.f + expf(-x)); }
DI float fsilu(float x) { return x * __builtin_amdgcn_rcpf(1.f + __builtin_amdgcn_exp2f(-1.44269504089f * x)); }
DI float fsigmoid(float x) { return __builtin_amdgcn_rcpf(1.f + __builtin_amdgcn_exp2f(-1.44269504089f * x)); }
template <int CTRL, int RM, bool BC> DI float dpp_add_src(float v) { return __builtin_bit_cast(float, __builtin_amdgcn_update_dpp(0, __builtin_bit_cast(int, v), CTRL, RM, 0xf, BC)); }
DI float wave_sum(float v) {
    v += dpp_add_src<0x111, 0xf, true>(v); v += dpp_add_src<0x112, 0xf, true>(v); v += dpp_add_src<0x114, 0xf, true>(v); v += dpp_add_src<0x118, 0xf, true>(v);
    v += dpp_add_src<0x142, 0xa, false>(v);
    v += dpp_add_src<0x143, 0xc, false>(v);
    return __builtin_bit_cast(float, __builtin_amdgcn_readlane(__builtin_bit_cast(int, v), 63));
}
DI u32x4 pack8(f32x4 lo, f32x4 hi) { u32x4 w; w.x = pk2(lo.x, lo.y); w.y = pk2(lo.z, lo.w); w.z = pk2(hi.x, hi.y); w.w = pk2(hi.z, hi.w); return w; }
DI void unpack8(u32x4 v, float* f) { f[0] = lo_f(v.x); f[1] = hi_f(v.x); f[2] = lo_f(v.y); f[3] = hi_f(v.y); f[4] = lo_f(v.z); f[5] = hi_f(v.z); f[6] = lo_f(v.w); f[7] = hi_f(v.w); }

struct CvtTile { const float* src; bf16_t* dst; int K; };
DI bool cvt_tile(const P& p, int l, int it, CvtTile& t, int& ldn) {
    bf16_t* WB = (bf16_t*)(p.ws + O_W);
    const int n_in = (1024 / 64) * (NIN / 64), n_pa = (256 / 64) * (1024 / 64), n_pb = (512 / 64) * (1024 / 64), n_o = 16 * 16, n_up = 16 * (NUP / 64), n_dn = (DFF / 64) * 16;
    const int total = n_in + n_pa + n_pb + n_o + n_up + n_dn;
    if (it >= total) return false;
    int r = it; const float* W; int K, N, skip = 1 << 30; bf16_t* WT;
    if (r < n_in) { W = p.w_in + (size_t)l * 1024 * INW; K = 1024; N = NIN; ldn = INW; skip = 3840; WT = WB + W_IN; }
    else if ((r -= n_in) < n_pa) { W = p.w_pa + (size_t)l * 256 * 1024; K = 256; N = 1024; ldn = 1024; WT = WB + W_PA; }
    else if ((r -= n_pa) < n_pb) { W = p.w_pb + (size_t)l * 512 * 1024; K = 512; N = 1024; ldn = 1024; WT = WB + W_PB; }
    else if ((r -= n_pb) < n_o) { W = p.w_o + (size_t)l * 1024 * 1024; K = 1024; N = 1024; ldn = 1024; WT = WB + W_O; }
    else if ((r -= n_o) < n_up) { W = p.w_up + (size_t)l * 1024 * NUP; K = 1024; N = NUP; ldn = NUP; WT = WB + W_UP; }
    else { r -= n_up; W = p.w_down + (size_t)l * DFF * 1024; K = DFF; N = 1024; ldn = 1024; WT = WB + W_DN; }
    const int nnt = N / 64, kt = r / nnt, nt = r % nnt, n0 = nt * 64, k0 = kt * 64;
    int ns = n0 >= skip ? n0 + 8 : n0;
    if (N == NUP) { const int tt = n0 >> 8, o = n0 & 255; ns = o < 128 ? 128 * tt + o : DFF + 128 * tt + (o - 128); }
    t.src = W + (size_t)k0 * ldn + ns; t.dst = WT + (size_t)n0 * K + k0; t.K = K;
    return true;
}
DI void ph_convert(const P& p, int l, unsigned char* lds) {
    float* tile = (float*)lds;
    CvtTile cur, nxt; int ldn = 0, ldn2 = 0;
    f32x4 r0, r1;
    bool have = cvt_tile(p, l, blockIdx.x, cur, ldn);
    { const int tid = tidx(), kr = tid >> 4, n4 = (tid & 15) * 4;
      if (have) { r0 = *(const f32x4*)(cur.src + (size_t)kr * ldn + n4); r1 = *(const f32x4*)(cur.src + (size_t)(kr + 32) * ldn + n4); } }
    for (int it = blockIdx.x; have; it += gridDim.x) {
        const int tid = tidx(), kr = tid >> 4, n4 = (tid & 15) * 4;
#pragma unroll
        for (int e = 0; e < 4; ++e) { tile[kr * 65 + n4 + e] = r0[e]; tile[(kr + 32) * 65 + n4 + e] = r1[e]; }
        lds_barrier();
        const bool hn = cvt_tile(p, l, it + gridDim.x, nxt, ldn2);
        if (hn) { r0 = *(const f32x4*)(nxt.src + (size_t)kr * ldn2 + n4); r1 = *(const f32x4*)(nxt.src + (size_t)(kr + 32) * ldn2 + n4); }
        { const int n = tid >> 3, k8 = (tid & 7) * 8;
          const float* tp = tile + k8 * 65 + n;
          *(u32x4*)(cur.dst + (size_t)n * cur.K + k8) = pack8((f32x4){tp[0], tp[65], tp[130], tp[195]}, (f32x4){tp[260], tp[325], tp[390], tp[455]}); }
        lds_barrier();
        cur = nxt; ldn = ldn2; have = hn;
    }
}

template <bool SRCBF> DI void ph_rmsnorm(const P& p, const void* __restrict__ src_, const float* __restrict__ w, int bg_layer, unsigned char* lds_) {
    const float* src = (const float*)src_; const bf16_t* srcb = (const bf16_t*)src_;
    const int lane = tidx() & 63, wave = tidx() >> 6;
    bf16_t* XN = (bf16_t*)(p.ws + O_XN);
    float* BG = (float*)(p.ws + O_BG);
    float* tbl = (float*)lds_;
    if (bg_layer >= 0) {
        const float* wi = p.w_in + (size_t)bg_layer * 1024 * INW + 3840;
        const int tid = tidx();
#pragma unroll
        for (int i = 0; i < 4; ++i) { const int idx = tid + 512 * i, k = idx >> 1, hf = idx & 1;
            const f32x4 v = *(const f32x4*)(wi + (size_t)k * INW + 4 * hf);
#pragma unroll
            for (int e = 0; e < 4; ++e) tbl[(4 * hf + e) * 1024 + k] = v[e]; }
        __syncthreads();
    }
    for (int row = blockIdx.x * 8 + wave; row < T_; row += gridDim.x * 8) {
        f32x4 v[4]; float ss = 0.f;
        if (SRCBF) { const u32x2* xb = (const u32x2*)(srcb + (size_t)row * DM) + lane;
#pragma unroll
            for (int j = 0; j < 4; ++j) { const u32x2 q = xb[64 * j]; v[j] = (f32x4){lo_f(q.x), hi_f(q.x), lo_f(q.y), hi_f(q.y)}; } }
        else { const f32x4* xr = (const f32x4*)(src + (size_t)row * DM) + lane;
#pragma unroll
            for (int j = 0; j < 4; ++j) v[j] = xr[64 * j]; }
#pragma unroll
        for (int j = 0; j < 4; ++j) ss += v[j].x * v[j].x + v[j].y * v[j].y + v[j].z * v[j].z + v[j].w * v[j].w;
        ss = wave_sum(ss);
        const float r = 1.f / sqrtf(ss * (1.f / DM) + 1e-6f);
#pragma unroll
        for (int j = 0; j < 4; ++j) { const f32x4 ww = ((const f32x4*)w)[lane + 64 * j]; v[j] = v[j] * r * ww; }
        u32x2* o = (u32x2*)(XN + (size_t)row * DM) + lane;
#pragma unroll
        for (int j = 0; j < 4; ++j) { u32x2 q; q.x = pk2(v[j].x, v[j].y); q.y = pk2(v[j].z, v[j].w); o[64 * j] = q; }
        if (bg_layer >= 0) {
            float a[8];
#pragma unroll
            for (int c = 0; c < 8; ++c) { a[c] = 0.f;
#pragma unroll
                for (int j = 0; j < 4; ++j) { const f32x4 tw = *(const f32x4*)(tbl + c * 1024 + 4 * (lane + 64 * j)); a[c] += v[j].x * tw.x + v[j].y * tw.y + v[j].z * tw.z + v[j].w * tw.w; } }
#pragma unroll
            for (int c = 0; c < 8; ++c) a[c] = wave_sum(a[c]);
            if (lane == 0) {
                const float* alog = p.dn_a_log + bg_layer * 4; const float* dtb = p.dn_dt_bias + bg_layer * 4;
                float o8[8];
#pragma unroll
                for (int h = 0; h < 4; ++h) {
                    o8[h] = sigmoidf_(a[h]);
                    const float z = a[4 + h] + dtb[h];
                    const float sp = z > 20.f ? z : log1pf(expf(z));
                    o8[4 + h] = -expf(alog[h]) * sp;
                }
                f32x4* bo = (f32x4*)(BG + (size_t)row * 8);
                bo[0] = (f32x4){o8[0], o8[1], o8[2], o8[3]}; bo[1] = (f32x4){o8[4], o8[5], o8[6], o8[7]};
            }
        }
    }
}

template <class Epi>
DI void gemm_nv(const bf16_t* __restrict__ A, const bf16_t* __restrict__ WT, int M, int N, int K, const Epi& epi) {
    const int lane = tidx() & 63, wave = tidx() >> 6, fr = lane & 15, fq = lane >> 4;
    const int nMt = M / 32, nNt = N / 64, nU = nMt * nNt;
    for (int u = blockIdx.x * 8 + wave; u < nU; u += gridDim.x * 8) {
        const int mt = u % nMt, nt = u / nMt, row0 = mt * 32, col0 = nt * 64;
        f32x4 acc[2][2][2];
#pragma unroll
        for (int m = 0; m < 2; ++m)
#pragma unroll
            for (int g = 0; g < 2; ++g)
#pragma unroll
                for (int nb = 0; nb < 2; ++nb) acc[m][g][nb] = (f32x4){0.f, 0.f, 0.f, 0.f};
        const bf16_t* ap0 = A + (size_t)(row0 + fr) * K + 8 * fq;
        const bf16_t* ap1 = ap0 + (size_t)16 * K;
        const bf16_t* wp00 = WT + (size_t)(col0 + 8 * (fr >> 2) + (fr & 3)) * K + 8 * fq;
        const bf16_t* wp01 = wp00 + (size_t)4 * K;
        const bf16_t* wp10 = wp00 + (size_t)32 * K;
        const bf16_t* wp11 = wp10 + (size_t)4 * K;
#pragma unroll 2
        for (int k0 = 0; k0 < K; k0 += 32) {
            const bf16x8 a0 = *(const bf16x8*)(ap0 + k0), a1 = *(const bf16x8*)(ap1 + k0);
            const bf16x8 w00 = *(const bf16x8*)(wp00 + k0), w01 = *(const bf16x8*)(wp01 + k0), w10 = *(const bf16x8*)(wp10 + k0), w11 = *(const bf16x8*)(wp11 + k0);
            acc[0][0][0] = __builtin_amdgcn_mfma_f32_16x16x32_bf16(w00, a0, acc[0][0][0], 0, 0, 0);
            acc[0][0][1] = __builtin_amdgcn_mfma_f32_16x16x32_bf16(w01, a0, acc[0][0][1], 0, 0, 0);
            acc[0][1][0] = __builtin_amdgcn_mfma_f32_16x16x32_bf16(w10, a0, acc[0][1][0], 0, 0, 0);
            acc[0][1][1] = __builtin_amdgcn_mfma_f32_16x16x32_bf16(w11, a0, acc[0][1][1], 0, 0, 0);
            acc[1][0][0] = __builtin_amdgcn_mfma_f32_16x16x32_bf16(w00, a1, acc[1][0][0], 0, 0, 0);
            acc[1][0][1] = __builtin_amdgcn_mfma_f32_16x16x32_bf16(w01, a1, acc[1][0][1], 0, 0, 0);
            acc[1][1][0] = __builtin_amdgcn_mfma_f32_16x16x32_bf16(w10, a1, acc[1][1][0], 0, 0, 0);
            acc[1][1][1] = __builtin_amdgcn_mfma_f32_16x16x32_bf16(w11, a1, acc[1][1][1], 0, 0, 0);
        }
#pragma unroll
        for (int m = 0; m < 2; ++m)
#pragma unroll
            for (int g = 0; g < 2; ++g) epi(row0 + 16 * m + fr, col0 + 32 * g + 8 * fq, acc[m][g][0], acc[m][g][1]);
    }
}

struct EpiIn {
    bf16_t *QKV, *DQKV, *DZ, *SG; int coff;
    struct Pre {}; DI Pre load(int, int) const { return Pre{}; }
    DI void apply(int row, int col, f32x4 lo, f32x4 hi, const Pre&) const { (*this)(row, col + coff, lo, hi); }
    DI void operator()(int row, int col, f32x4 lo, f32x4 hi) const {
        if (col < 2304) *(u32x4*)(QKV + (size_t)row * 2304 + col) = pack8(lo, hi);
        else if (col < 3840) *(u32x4*)(DQKV + (size_t)row * 1536 + (col - 2304)) = pack8(lo, hi);
        else if (col < 4352) *(u32x4*)(DZ + (size_t)row * 512 + (col - 3840)) = pack8(lo, hi);
        else {
#pragma unroll
            for (int e = 0; e < 4; ++e) { lo[e] = fsigmoid(lo[e]); hi[e] = fsigmoid(hi[e]); }
            *(u32x4*)(SG + (size_t)row * 2048 + (col - 4352)) = pack8(lo, hi);
        }
    }
};
template <int ADD> struct EpiGate {
    bf16_t* Y; const bf16_t* SG; int goff;
    struct Pre { u32x4 g, y; };
    DI Pre load(int row, int col) const { Pre q; q.g = *(const u32x4*)(SG + (size_t)row * 2048 + goff + col); if (ADD) q.y = *(const u32x4*)(Y + (size_t)row * DM + col); else q.y = (u32x4){0u, 0u, 0u, 0u}; return q; }
    DI void apply(int row, int col, f32x4 lo, f32x4 hi, const Pre& q) const {
        float g[8], o[8]; unpack8(q.g, g); unpack8(q.y, o);
        f32x4 a, b;
#pragma unroll
        for (int e = 0; e < 4; ++e) { a[e] = g[e] * lo[e] + o[e]; b[e] = g[4 + e] * hi[e] + o[4 + e]; }
        *(u32x4*)(Y + (size_t)row * DM + col) = pack8(a, b);
    }
};
struct EpiRes {
    const float* X; float* R;
    struct Pre { f32x4 x0, x1; };
    DI Pre load(int row, int col) const { const f32x4* xp = (const f32x4*)(X + (size_t)row * DM + col); Pre q; q.x0 = xp[0]; q.x1 = xp[1]; return q; }
    DI void apply(int row, int col, f32x4 lo, f32x4 hi, const Pre& q) const { f32x4* rp = (f32x4*)(R + (size_t)row * DM + col); rp[0] = q.x0 + lo; rp[1] = q.x1 + hi; }
};
template <bool XF32> struct EpiResB {
    const void* X; bf16_t* R;
    struct Pre { f32x4 x0, x1; };
    DI Pre load(int row, int col) const {
        Pre q;
        if (XF32) { const f32x4* xp = (const f32x4*)((const float*)X + (size_t)row * DM + col); q.x0 = xp[0]; q.x1 = xp[1]; }
        else { const u32x4 u = *(const u32x4*)((const bf16_t*)X + (size_t)row * DM + col); q.x0 = (f32x4){lo_f(u.x), hi_f(u.x), lo_f(u.y), hi_f(u.y)}; q.x1 = (f32x4){lo_f(u.z), hi_f(u.z), lo_f(u.w), hi_f(u.w)}; }
        return q;
    }
    DI void apply(int row, int col, f32x4 lo, f32x4 hi, const Pre& q) const { *(u32x4*)(R + (size_t)row * DM + col) = pack8(q.x0 + lo, q.x1 + hi); }
};
struct EpiUp {
    bf16_t* U;
    struct Pre {}; DI Pre load(int, int) const { return Pre{}; }
    DI void apply(int row, int col, f32x4 lo, f32x4 hi, const Pre&) const { (*this)(row, col, lo, hi); }
    DI void operator()(int row, int col, f32x4 lo, f32x4 hi) const { *(u32x4*)(U + (size_t)row * NUP + col) = pack8(lo, hi); }
};

namespace pg8 {
#define PG8_LAS __attribute__((address_space(3)))
typedef unsigned short bf16_t;
typedef short bf16x8 __attribute__((ext_vector_type(8)));
typedef float f32x4 __attribute__((ext_vector_type(4)));
typedef unsigned u32x4 __attribute__((ext_vector_type(4)));
constexpr int BM = 256, BK = 64, HALF = 128, HTB = HALF * BK * 2  , STAGE_BYTES = 8 * HTB, NXCD = 8, WGM = 8;

__host__ __device__ __forceinline__ int lds_byte(int r, int c) { const int st = (r >> 4) * 2 + (c >> 5), rr = r & 15, cc = c & 31, ob = rr * 64 + cc * 2; return st * 1024 + (ob ^ (((ob >> 9) & 1) << 5)); }
__host__ __device__ __forceinline__ void stage_rc(int b, int& R, int& C) { const int st = b / 1024, sb = b % 1024, swz = sb ^ (((sb >> 9) & 1) << 5); R = (st >> 1) * 16 + swz / 64; C = (st & 1) * 32 + (swz % 64) / 2; }
__host__ __device__ __forceinline__ int perm32(int rho) { const int n = rho >> 4, i = rho & 15; return 8 * (i >> 2) + 4 * n + (i & 3); }

struct Unit { int pm, pn; };
struct Gemm { const bf16_t* A; const bf16_t* Bt; int M, N, K; };
struct StaticOrder {
    int nM, nN, nwg, G, c;
    __host__ __device__ void init(int M, int N, int G_, int c_) { nM = M / BM; nN = N / BM; nwg = nM * nN; G = G_; c = c_; }
    __host__ __device__ bool next(int i, Unit& u) const {
        const long L = (long)i * G + c; if (L >= nwg) return false;
        int wgid = (int)L; { const int q = nwg / NXCD, r = nwg % NXCD, xcd = wgid % NXCD, off = wgid / NXCD; wgid = (xcd < r ? xcd * (q + 1) : r * (q + 1) + (xcd - r) * q) + off; }
        const int nig = WGM * nN, gid = wgid / nig, fm = gid * WGM, gsz = (nM - fm) < WGM ? (nM - fm) : WGM;
        u.pm = fm + ((wgid % nig) % gsz); u.pn = (wgid % nig) / gsz; return true;
    }
    __device__ __forceinline__ void a_ready(const Unit&) const {}
    __device__ __forceinline__ void done(const Unit&) const {}
};
template <class Epi, class Sched>
__device__ __forceinline__ void gemm_phase(PG8_LAS unsigned char* lds, const Gemm g, const Sched& S, const Epi& E) {
    int tid_ = threadIdx.x; asm volatile("" : "+v"(tid_));
    const int tid = tid_, wid = __builtin_amdgcn_readfirstlane(tid >> 6), lane = tid & 63, wr = wid >> 2, wc = wid & 3, fr = lane & 15, fq = lane >> 4;
    const int K = g.K, nt = K / BK;
    unsigned voffA[2], voffB[2];
#pragma unroll
    for (int i = 0; i < 2; ++i) { int R, C; stage_rc(tid * 16 + i * 8192, R, C); const int Rb = Epi::PERM ? ((R & ~31) + perm32(R & 31)) : R;
        voffA[i] = (unsigned)(R * K + C) * 2u; voffB[i] = (unsigned)(Rb * K + C) * 2u; }
    const size_t kstep = (size_t)(BK * 2);
    const size_t hstep = (size_t)HALF * K * 2;
    const size_t tstep = 2 * hstep;
    const unsigned ldsw = (unsigned)wid * 1024u;
    const int aoff = lds_byte(wr * 64 + fr, fq * 8), boff = lds_byte(wc * 32 + fr, fq * 8);
#define PG8_SA(b, h) (((b) * 2 + (h)) * HTB)
#define PG8_SB(b, h) ((4 + (b) * 2 + (h)) * HTB)
#define PG8_STAGE(bufoff, gbase, voff) do { _Pragma("unroll") for (int _i = 0; _i < 2; ++_i) \
        __builtin_amdgcn_global_load_lds((const unsigned*)((const char*)(gbase) + (voff)[_i]), (PG8_LAS unsigned*)(lds + (bufoff) + ldsw + _i * 8192), 16, 0, 0); } while (0)
#define PG8_LDA(dst, b, h) do { _Pragma("unroll") for (int m = 0; m < 4; ++m) _Pragma("unroll") for (int k = 0; k < 2; ++k) dst[m][k] = *(const PG8_LAS bf16x8*)(lds + PG8_SA(b, h) + aoff + m * 2048 + k * 1024); } while (0)
#define PG8_LDB(dst, b, h) do { _Pragma("unroll") for (int n = 0; n < 2; ++n) _Pragma("unroll") for (int k = 0; k < 2; ++k) dst[n][k] = *(const PG8_LAS bf16x8*)(lds + PG8_SB(b, h) + boff + n * 2048 + k * 1024); } while (0)
#define PG8_MMA(ai, bj, At, Bt) do { __builtin_amdgcn_s_setprio(1); _Pragma("unroll") for (int m = 0; m < 4; ++m) _Pragma("unroll") for (int n = 0; n < 2; ++n) _Pragma("unroll") for (int k = 0; k < 2; ++k) \
        acc[ai][bj][m][n] = __builtin_amdgcn_mfma_f32_16x16x32_bf16(Bt[n][k], At[m][k], acc[ai][bj][m][n], 0, 0, 0); __builtin_amdgcn_s_setprio(0); } while (0)
#define PG8_WAIT_V(n) asm volatile("s_waitcnt vmcnt(" #n ")" ::: "memory")
#define PG8_WAIT_L(n) asm volatile("s_waitcnt lgkmcnt(" #n ")" ::: "memory")
#define PG8_BAR __builtin_amdgcn_s_barrier()
#define PG8_SCHED __builtin_amdgcn_sched_barrier(0)
    Unit cur, nxt; int ui = 0;
    if (!S.next(0, cur)) return;
    f32x4 acc[2][2][4][2];
#pragma unroll
    for (int a = 0; a < 2; ++a)
#pragma unroll
        for (int b = 0; b < 2; ++b)
#pragma unroll
            for (int m = 0; m < 4; ++m)
#pragma unroll
                for (int n = 0; n < 2; ++n) acc[a][b][m][n] = (f32x4){0.f, 0.f, 0.f, 0.f};
    bf16x8 At[4][2], B0[2][2], B1[2][2];
    const char* cA = (const char*)g.A + (size_t)cur.pm * tstep; const char* cB = (const char*)g.Bt + (size_t)cur.pn * tstep;
    S.a_ready(cur);
    PG8_STAGE(PG8_SB(0, 0), cB, voffB); PG8_STAGE(PG8_SA(0, 0), cA, voffA); PG8_STAGE(PG8_SB(0, 1), cB + hstep, voffB); PG8_STAGE(PG8_SA(0, 1), cA + hstep, voffA);
    if (wr == 1) PG8_BAR;
    PG8_WAIT_V(4); PG8_BAR;
    PG8_STAGE(PG8_SB(1, 0), cB + kstep, voffB); PG8_STAGE(PG8_SA(1, 0), cA + kstep, voffA); PG8_STAGE(PG8_SB(1, 1), cB + hstep + kstep, voffB);
    PG8_WAIT_V(6); PG8_BAR;
    for (;;) {
        const bool has_next = S.next(ui + 1, nxt);
        const char* nA = has_next ? (const char*)g.A + (size_t)nxt.pm * tstep : cA; const char* nB = has_next ? (const char*)g.Bt + (size_t)nxt.pn * tstep : cB;
        for (int t = 0; t < nt; t += 2) {
            const bool last = (t == nt - 2);
            const char* a1 = cA + (size_t)(t + 1) * kstep;
            const char* a2 = last ? nA : cA + (size_t)(t + 2) * kstep; const char* b2 = last ? nB : cB + (size_t)(t + 2) * kstep;
            const char* a3 = a2 + kstep; const char* b3 = b2 + kstep;
            if (last && has_next) S.a_ready(nxt);
            PG8_LDB(B0, 0, 0); PG8_SCHED; PG8_LDA(At, 0, 0); PG8_STAGE(PG8_SA(1, 1), a1 + hstep, voffA);
            PG8_WAIT_L(8); PG8_BAR; PG8_WAIT_L(0); PG8_MMA(0, 0, At, B0); PG8_BAR; PG8_SCHED;
            PG8_LDB(B1, 0, 1); PG8_STAGE(PG8_SB(0, 0), b2, voffB);
            PG8_BAR; PG8_WAIT_L(0); PG8_MMA(0, 1, At, B1); PG8_BAR;
            PG8_LDA(At, 0, 1); PG8_STAGE(PG8_SA(0, 0), a2, voffA);
            PG8_BAR; PG8_WAIT_L(0); PG8_MMA(1, 0, At, B0); PG8_BAR; PG8_SCHED;
            PG8_STAGE(PG8_SB(0, 1), b2 + hstep, voffB);
            PG8_WAIT_V(6); PG8_BAR; PG8_MMA(1, 1, At, B1); PG8_BAR;
            PG8_LDB(B0, 1, 0); PG8_SCHED; PG8_LDA(At, 1, 0); PG8_STAGE(PG8_SA(0, 1), a2 + hstep, voffA);
            PG8_WAIT_L(8); PG8_BAR; PG8_WAIT_L(0); PG8_MMA(0, 0, At, B0); PG8_BAR; PG8_SCHED;
            PG8_LDB(B1, 1, 1); PG8_STAGE(PG8_SB(1, 0), b3, voffB);
            PG8_BAR; PG8_WAIT_L(0); PG8_MMA(0, 1, At, B1); PG8_BAR;
            PG8_LDA(At, 1, 1); PG8_STAGE(PG8_SA(1, 0), a3, voffA);
            PG8_BAR; PG8_WAIT_L(0); PG8_MMA(1, 0, At, B0); PG8_BAR; PG8_SCHED;
            PG8_STAGE(PG8_SB(1, 1), b3 + hstep, voffB);
            PG8_WAIT_V(6); PG8_BAR; PG8_MMA(1, 1, At, B1); PG8_BAR;
        }
        if constexpr (!Epi::AFTER_DRAIN) { E(acc, cur, wr, wc, fr, fq); S.done(cur); }
        if (!has_next) break;
#pragma unroll
        for (int a = 0; a < 2; ++a)
#pragma unroll
            for (int b = 0; b < 2; ++b)
#pragma unroll
                for (int m = 0; m < 4; ++m)
#pragma unroll
                    for (int n = 0; n < 2; ++n) acc[a][b][m][n] = (f32x4){0.f, 0.f, 0.f, 0.f};
        cur = nxt; cA = nA; cB = nB; ++ui;
    }
    PG8_WAIT_V(0);
    if (wr == 0) PG8_BAR;
    PG8_BAR;
    if constexpr (Epi::AFTER_DRAIN) { E.fused(acc, cur, wr, wc, fr, fq, lds, wid, lane); S.done(cur); }
#undef PG8_SA
#undef PG8_SB
#undef PG8_STAGE
#undef PG8_LDA
#undef PG8_LDB
#undef PG8_MMA
#undef PG8_WAIT_V
#undef PG8_WAIT_L
#undef PG8_BAR
#undef PG8_SCHED
}
}

template <class F> struct EpiAdapt {
    static constexpr bool PERM = true, AFTER_DRAIN = false;
    F f;
    DI void operator()(const pg8::f32x4 (&acc)[2][2][4][2], const pg8::Unit& u, int wr, int wc, int fr, int fq) const {
        const int row0 = u.pm * 256 + wr * 64 + fr, col0 = u.pn * 256 + wc * 32 + 8 * fq;
#pragma unroll
        for (int ai = 0; ai < 2; ++ai) {
            typename F::Pre pre[4][2];
#pragma unroll
            for (int m = 0; m < 4; ++m)
#pragma unroll
                for (int bj = 0; bj < 2; ++bj) pre[m][bj] = f.load(row0 + ai * 128 + m * 16, col0 + bj * 128);
#pragma unroll
            for (int m = 0; m < 4; ++m)
#pragma unroll
                for (int bj = 0; bj < 2; ++bj) f.apply(row0 + ai * 128 + m * 16, col0 + bj * 128, acc[ai][bj][m][0], acc[ai][bj][m][1], pre[m][bj]);
            if constexpr (sizeof(typename F::Pre) > 1) { asm volatile("" ::: "memory"); __builtin_amdgcn_sched_barrier(0); }
        }
    }
};
template <class F> DI void gemm_fast(unsigned char* lds, const bf16_t* A, const bf16_t* WT, int M, int N, int K, const F& f) {
    asm volatile("" : "+s"(K));
    pg8::Gemm g{A, WT, M, N, K}; pg8::StaticOrder S; S.init(M, N, (int)gridDim.x, (int)blockIdx.x);
    EpiAdapt<F> E{f};
    pg8::gemm_phase((PG8_LAS unsigned char*)lds, g, S, E);
}
#ifndef FAST_GEMM
#define FAST_GEMM 1
#endif
#if FAST_GEMM
#define GEMM(A, W, M, N, K, e) gemm_fast(lds, A, W, M, N, K, e)
#else
#define GEMM(A, W, M, N, K, e) gemm_nv(A, W, M, N, K, e)
#endif

DI void ph_attn_naive(const P& p) {
    const bf16_t* QKV = (const bf16_t*)(p.ws + O_QKV); bf16_t* OG = (bf16_t*)((unsigned char*)p.out + 64 * MiB); float* LSE = (float*)((unsigned char*)p.out + 112 * MiB);
    for (int it = blockIdx.x * NT + tidx(); it < T_ * 12; it += gridDim.x * NT) {
        const int t = it / 12, gh = it % 12, g = gh >> 2, h = gh & 3;
        const int d = g == 0 ? 1 : (g == 1 ? 4 : 16);
        const int pos = t % S_;
        int nk = pos / d; nk = (nk > 128 ? 128 : nk) + 1;
        float q[64], o[64];
        const bf16_t* qp = QKV + (size_t)t * 2304 + g * 256 + h * 64;
#pragma unroll
        for (int i = 0; i < 8; ++i) unpack8(((const u32x4*)qp)[i], q + 8 * i);
#pragma unroll
        for (int i = 0; i < 64; ++i) o[i] = 0.f;
        float m = -1e30f, den = 0.f;
        for (int j = 0; j < nk; ++j) {
            const bf16_t* kp = QKV + (size_t)(t - j * d) * 2304 + 768 + g * 256 + h * 64;
            float s = 0.f;
#pragma unroll
            for (int i = 0; i < 8; ++i) { float kk[8]; unpack8(((const u32x4*)kp)[i], kk);
#pragma unroll
                for (int e = 0; e < 8; ++e) s += q[8 * i + e] * kk[e]; }
            s *= 0.125f;
            const float mn = fmaxf(m, s), corr = expf(m - mn), pj = expf(s - mn);
            den = den * corr + pj; m = mn;
            const bf16_t* vp = kp + 768;
#pragma unroll
            for (int i = 0; i < 8; ++i) { float vv[8]; unpack8(((const u32x4*)vp)[i], vv);
#pragma unroll
                for (int e = 0; e < 8; ++e) o[8 * i + e] = o[8 * i + e] * corr + pj * vv[e]; }
        }
        const float inv = 1.f / den;
        bf16_t* op = OG + ((size_t)g * T_ + t) * 256 + h * 64;
#pragma unroll
        for (int i = 0; i < 8; ++i) { u32x4 w; w.x = pk2(o[8 * i] * inv, o[8 * i + 1] * inv); w.y = pk2(o[8 * i + 2] * inv, o[8 * i + 3] * inv); w.z = pk2(o[8 * i + 4] * inv, o[8 * i + 5] * inv); w.w = pk2(o[8 * i + 6] * inv, o[8 * i + 7] * inv); ((u32x4*)op)[i] = w; }
        LSE[((size_t)g * T_ + t) * 4 + h] = m + logf(den);
    }
}

DI void ph_dn_naive(const P& p, int l, unsigned char* lds_, float* __restrict__ OB) {
    float* kq = (float*)lds_;
    float* red = kq + 2 * 2 * 128;
    const bf16_t* DQKV = (const bf16_t*)(p.ws + O_DQKV); const float* BG = (const float*)(p.ws + O_BG);
    const int tid = tidx(), c = tid >> 2, part = tid & 3, wig = tid >> 6, lane = tid & 63;
    for (int pair = blockIdx.x; pair < 32; pair += gridDim.x) {
        const int b = pair >> 2, h = pair & 3;
        const float* cw = p.dn_conv_w + (size_t)l * 4 * 1536 + h * 128 + c;
        float wq[4], wk[4], wv[4];
#pragma unroll
        for (int j = 0; j < 4; ++j) { wq[j] = cw[j * 1536]; wk[j] = cw[j * 1536 + 512]; wv[j] = cw[j * 1536 + 1024]; }
        float hq0 = 0.f, hq1 = 0.f, hq2 = 0.f, hk0 = 0.f, hk1 = 0.f, hk2 = 0.f, hv0 = 0.f, hv1 = 0.f, hv2 = 0.f;
        float s[32];
#pragma unroll
        for (int i = 0; i < 32; ++i) s[i] = 0.f;
        const bf16_t* dp = DQKV + (size_t)(b * S_) * 1536 + h * 128 + c;
        bf16_t nq = dp[0], nk = dp[512], nv = dp[1024];
        for (int t = 0; t < S_; ++t) {
            const size_t row = (size_t)b * S_ + t;
            const float xq = bf2f(nq), xk = bf2f(nk), xv = bf2f(nv);
            if (t + 1 < S_) { const bf16_t* np = dp + (size_t)(t + 1) * 1536; nq = np[0]; nk = np[512]; nv = np[1024]; }
            float cq = wq[0] * hq0 + wq[1] * hq1 + wq[2] * hq2 + wq[3] * xq;
            float ck = wk[0] * hk0 + wk[1] * hk1 + wk[2] * hk2 + wk[3] * xk;
            float cv = wv[0] * hv0 + wv[1] * hv1 + wv[2] * hv2 + wv[3] * xv;
            hq0 = hq1; hq1 = hq2; hq2 = xq; hk0 = hk1; hk1 = hk2; hk2 = xk; hv0 = hv1; hv1 = hv2; hv2 = xv;
            cq = siluf_(cq); ck = siluf_(ck); cv = siluf_(cv);
            float sq = wave_sum(part ? 0.f : cq * cq), sk = wave_sum(part ? 0.f : ck * ck);
            const int par = t & 1;
            float* rd = red + par * 16;
            if (lane == 0) { rd[wig * 2] = sq; rd[wig * 2 + 1] = sk; }
            __syncthreads();
            sq = 0.f; sk = 0.f;
#pragma unroll
            for (int w = 0; w < 8; ++w) { sq += rd[2 * w]; sk += rd[2 * w + 1]; }
            const float qn = cq * (1.f / sqrtf(sq + 1e-6f)) * 0.08838834764831845f, kn = ck * (1.f / sqrtf(sk + 1e-6f));
            float* kb = kq + par * 256; float* qb = kb + 128;
            if (!part) { kb[c] = kn; qb[c] = qn; }
            __syncthreads();
            const float beta = BG[row * 8 + h], eg = expf(BG[row * 8 + 4 + h]);
            const float* kbh = kb + part * 32; const float* qbh = qb + part * 32;
            float kS = 0.f;
#pragma unroll
            for (int i = 0; i < 32; ++i) kS += kbh[i] * s[i];
            kS += __shfl_xor(kS, 1); kS += __shfl_xor(kS, 2);
            const float coef = beta * (cv - eg * kS);
            float o = 0.f;
#pragma unroll
            for (int i = 0; i < 32; ++i) { s[i] = eg * s[i] + kbh[i] * coef; o += qbh[i] * s[i]; }
            o += __shfl_xor(o, 1); o += __shfl_xor(o, 2);
            if (!part) OB[row * 512 + h * 128 + c] = o;
        }
    }
}


constexpr size_t O_PW = O_QKV, O_PQD = O_QKV + 8192 * 2, O_PKDT = O_QKV + 16384 * 2, O_PUT = O_QKV + 24576 * 2, O_PQK = O_QKV + 32768 * 2;
constexpr size_t RS = 36864;
#define MFMA16(a, b, c) __builtin_amdgcn_mfma_f32_16x16x32_bf16((a), (b), (c), 0, 0, 0)
DI void ph_dn_prep(const P& p, int l, unsigned char* lds_) {
    bf16_t* Qt = (bf16_t*)lds_;
    bf16_t* Kt = Qt + 64 * 136;
    bf16_t* VBT = Kt + 64 * 136;
    bf16_t* KBGT = VBT + 128 * 72;
    bf16_t* AI = KBGT + 128 * 72;
    float* Mf = (float*)(AI + 64 * 72);
    float* gcs = Mf + 64 * 68;
    const bf16_t* DQKV = (const bf16_t*)(p.ws + O_DQKV); const float* BG = (const float*)(p.ws + O_BG);
    bf16_t* PW = (bf16_t*)(p.ws + O_PW); bf16_t* PQD = (bf16_t*)(p.ws + O_PQD); bf16_t* PKDT = (bf16_t*)(p.ws + O_PKDT); bf16_t* PUT = (bf16_t*)(p.ws + O_PUT); bf16_t* PQK = (bf16_t*)(p.ws + O_PQK);
    float* GL = (float*)(p.ws + O_GL);
    for (int ci = blockIdx.x; ci < 2048; ci += gridDim.x) {
        const int tid = tidx(), lane = tid & 63, w = __builtin_amdgcn_readfirstlane(tid >> 6), fr = lane & 15, fq = lane >> 4;
        const int cg_ = tid % 48, tg = tid / 48, part = cg_ >> 4, c8 = (cg_ & 15) * 8;
        const int b = ci >> 8, h = (ci >> 6) & 3, n = ci & 63;
        const size_t row0 = (size_t)b * S_ + n * 64;
        u32x4 raw[11];
        if (tid >= 448) {
            float x = BG[(row0 + lane) * 8 + 4 + h];
            const float be = BG[(row0 + lane) * 8 + h];
#pragma unroll
            for (int o = 1; o < 64; o <<= 1) { const float v = __shfl_up(x, o); if (lane >= o) x += v; }
            gcs[lane] = x; gcs[64 + lane] = be;
        }
        if (tid < 384) {
#pragma unroll
            for (int r = 0; r < 11; ++r) {
                const int tk = tg * 8 - 3 + r;
                if (n * 64 + tk >= 0) raw[r] = *(const u32x4*)(DQKV + (row0 + tk) * 1536 + part * 512 + h * 128 + c8);
                else raw[r] = (u32x4){0u, 0u, 0u, 0u};
            }
        }
        lds_barrier();
        if (tid < 384) {
            const float* cwp = p.dn_conv_w + (size_t)l * 4 * 1536 + part * 512 + h * 128 + c8;
            float cw[4][8];
#pragma unroll
            for (int j = 0; j < 4; ++j) { const f32x4 a = *(const f32x4*)(cwp + j * 1536), bb = *(const f32x4*)(cwp + j * 1536 + 4);
                cw[j][0] = a.x; cw[j][1] = a.y; cw[j][2] = a.z; cw[j][3] = a.w; cw[j][4] = bb.x; cw[j][5] = bb.y; cw[j][6] = bb.z; cw[j][7] = bb.w; }
            float rn[8];
#pragma unroll
            for (int i = 0; i < 8; ++i) {
                float ss = 0.f;
#pragma unroll
                for (int e = 0; e < 8; ++e) {
                    float v = 0.f;
#pragma unroll
                    for (int j = 0; j < 4; ++j) { const unsigned u = raw[i + j][e >> 1]; v += cw[j][e] * ((e & 1) ? hi_f(u) : lo_f(u)); }
                    v = fsilu(v); ss += v * v;
                }
#pragma unroll
                for (int o = 1; o < 16; o <<= 1) ss += __shfl_xor(ss, o);
                rn[i] = part == 2 ? 1.f : (1.f / sqrtf(ss + 1e-6f)) * (part == 0 ? 0.08838834764831845f : 1.f);
            }
            const float gclast = gcs[63];
            float s1[8], s2[8];
#pragma unroll
            for (int i = 0; i < 8; ++i) { const int tok = tg * 8 + i; const float gc = gcs[tok], be = gcs[64 + tok];
                s1[i] = part == 0 ? expf(gc) : (part == 1 ? be * expf(gc) : be); s2[i] = expf(gclast - gc); }
#pragma unroll
            for (int hf = 0; hf < 2; ++hf) {
                float val[8][4];
#pragma unroll
                for (int i = 0; i < 8; ++i)
#pragma unroll
                    for (int e4 = 0; e4 < 4; ++e4) { const int e = 4 * hf + e4;
                        float v = 0.f;
#pragma unroll
                        for (int j = 0; j < 4; ++j) { const unsigned u = raw[i + j][e >> 1]; v += cw[j][e] * ((e & 1) ? hi_f(u) : lo_f(u)); }
                        val[i][e4] = fsilu(v) * rn[i]; }
                const int ch0 = c8 + 4 * hf;
                if (part == 0) {
#pragma unroll
                    for (int i = 0; i < 8; ++i) { const int tok = tg * 8 + i;
                        u32x2 a; a.x = pk2(val[i][0], val[i][1]); a.y = pk2(val[i][2], val[i][3]); *(u32x2*)(Qt + tok * 136 + ch0) = a;
                        u32x2 d; d.x = pk2(val[i][0] * s1[i], val[i][1] * s1[i]); d.y = pk2(val[i][2] * s1[i], val[i][3] * s1[i]); *(u32x2*)(PQD + (size_t)ci * RS + tok * 128 + ch0) = d; }
                } else if (part == 1) {
#pragma unroll
                    for (int i = 0; i < 8; ++i) { const int tok = tg * 8 + i;
                        u32x2 a; a.x = pk2(val[i][0], val[i][1]); a.y = pk2(val[i][2], val[i][3]); *(u32x2*)(Kt + tok * 136 + ch0) = a; }
#pragma unroll
                    for (int e4 = 0; e4 < 4; ++e4) {
                        *(u32x4*)(KBGT + (ch0 + e4) * 72 + tg * 8) = pack8((f32x4){val[0][e4] * s1[0], val[1][e4] * s1[1], val[2][e4] * s1[2], val[3][e4] * s1[3]}, (f32x4){val[4][e4] * s1[4], val[5][e4] * s1[5], val[6][e4] * s1[6], val[7][e4] * s1[7]});
                        *(u32x4*)(PKDT + (size_t)ci * RS + (ch0 + e4) * 64 + tg * 8) = pack8((f32x4){val[0][e4] * s2[0], val[1][e4] * s2[1], val[2][e4] * s2[2], val[3][e4] * s2[3]}, (f32x4){val[4][e4] * s2[4], val[5][e4] * s2[5], val[6][e4] * s2[6], val[7][e4] * s2[7]});
                    }
                } else {
#pragma unroll
                    for (int e4 = 0; e4 < 4; ++e4)
                        *(u32x4*)(VBT + (ch0 + e4) * 72 + tg * 8) = pack8((f32x4){val[0][e4] * s1[0], val[1][e4] * s1[1], val[2][e4] * s1[2], val[3][e4] * s1[3]}, (f32x4){val[4][e4] * s1[4], val[5][e4] * s1[5], val[6][e4] * s1[6], val[7][e4] * s1[7]});
                }
            }
        }
        if (tid == 0) GL[ci] = expf(gcs[63]);
        lds_barrier();
#pragma unroll
        for (int s = 0; s < 2; ++s) {
            const int tt = w * 2 + s, ct = tt >> 2, jt = tt & 3;
            if (jt <= ct) {
                f32x4 kk = {0.f, 0.f, 0.f, 0.f}, qk = {0.f, 0.f, 0.f, 0.f};
#pragma unroll
                for (int ks = 0; ks < 4; ++ks) {
                    const bf16x8 kc = *(const bf16x8*)(Kt + (ct * 16 + fr) * 136 + ks * 32 + 8 * fq);
                    const bf16x8 kj = *(const bf16x8*)(Kt + (jt * 16 + fr) * 136 + ks * 32 + 8 * fq);
                    const bf16x8 qc = *(const bf16x8*)(Qt + (ct * 16 + fr) * 136 + ks * 32 + 8 * fq);
                    kk = MFMA16(kc, kj, kk);
                    qk = MFMA16(kj, qc, qk);
                }
                { const int j = jt * 16 + fr; const float gj = gcs[j];
#pragma unroll
                  for (int jj = 0; jj < 4; ++jj) { const int c = ct * 16 + 4 * fq + jj;
                      Mf[c * 68 + j] = (j < c) ? gcs[64 + c] * kk[jj] * expf(gcs[c] - gj) : 0.f; } }
                { const int c = ct * 16 + fr; const float gc = gcs[c]; float o4[4];
#pragma unroll
                  for (int jj = 0; jj < 4; ++jj) { const int j = jt * 16 + 4 * fq + jj; o4[jj] = (j <= c) ? qk[jj] * expf(gc - gcs[j]) : 0.f; }
                  u32x2 wv; wv.x = pk2(o4[0], o4[1]); wv.y = pk2(o4[2], o4[3]);
                  *(u32x2*)(PQK + (size_t)ci * RS + c * 64 + jt * 16 + 4 * fq) = wv; }
            } else {
                const int c = ct * 16 + fr;
                *(u32x2*)(PQK + (size_t)ci * RS + c * 64 + jt * 16 + 4 * fq) = (u32x2){0u, 0u};
            }
        }
        lds_barrier();
        if (w == 0) {
            int lz = 0; asm volatile("" : "+v"(lz));
            const float* Mfz = Mf + lz;
            float X[64];
#pragma unroll
            for (int i = 0; i < 64; ++i) {
                f32x4 mv[16];
#pragma unroll
                for (int q = 0; q < (i + 3) / 4; ++q) mv[q] = *(const f32x4*)(Mfz + i * 68 + 4 * q);
                float a0 = (lane == i) ? 1.f : 0.f, a1 = 0.f, a2 = 0.f, a3 = 0.f;
#pragma unroll
                for (int j = 0; j < i; ++j) { const float t = mv[j >> 2][j & 3] * X[j]; if ((j & 3) == 0) a0 -= t; else if ((j & 3) == 1) a1 -= t; else if ((j & 3) == 2) a2 -= t; else a3 -= t; }
                X[i] = (a0 + a1) + (a2 + a3);
            }
#pragma unroll
            for (int i = 0; i < 64; ++i) AI[i * 72 + lane] = f2bf(X[i]);
        }
        lds_barrier();
#pragma unroll
        for (int ct = 0; ct < 4; ++ct) {
            f32x4 u = {0.f, 0.f, 0.f, 0.f}, ww = {0.f, 0.f, 0.f, 0.f};
#pragma unroll
            for (int ks = 0; ks < 2; ++ks) {
                const bf16x8 ai = *(const bf16x8*)(AI + (ct * 16 + fr) * 72 + ks * 32 + 8 * fq);
                const bf16x8 vb = *(const bf16x8*)(VBT + (w * 16 + fr) * 72 + ks * 32 + 8 * fq);
                const bf16x8 kb = *(const bf16x8*)(KBGT + (w * 16 + fr) * 72 + ks * 32 + 8 * fq);
                u = MFMA16(ai, vb, u);
                ww = MFMA16(kb, ai, ww);
            }
            { u32x2 wv; wv.x = pk2(u[0], u[1]); wv.y = pk2(u[2], u[3]); *(u32x2*)(PUT + (size_t)ci * RS + (w * 16 + fr) * 64 + ct * 16 + 4 * fq) = wv; }
            { u32x2 wv; wv.x = pk2(ww[0], ww[1]); wv.y = pk2(ww[2], ww[3]); *(u32x2*)(PW + (size_t)ci * RS + (ct * 16 + fr) * 128 + w * 16 + 4 * fq) = wv; }
        }
        lds_barrier();
    }
}

struct ScanOps { bf16x8 A4[4], KDf[2], QKf[2]; u32x2 Uf[2]; float gl; };
DI void scan_reload_a(const P& p, ScanOps& B, int ci, int role, int mt, int fr, int fq) {
    const bf16_t* base = (const bf16_t*)(p.ws + (role ? O_PQD : O_PW)) + (size_t)ci * RS + (mt * 16 + fr) * 128 + 8 * fq;
#pragma unroll
    for (int ks = 0; ks < 4; ++ks) B.A4[ks] = *(const bf16x8*)(base + ks * 32);
}
DI void scan_reload_x(const P& p, ScanOps& B, int ci, int role, int mt, int fr, int fq, int dv0) {
    if (role) {
        const bf16_t* q = (const bf16_t*)(p.ws + O_PQK) + (size_t)ci * RS + (mt * 16 + fr) * 64 + 8 * fq;
        B.QKf[0] = *(const bf16x8*)q; B.QKf[1] = *(const bf16x8*)(q + 32);
    } else {
        const bf16_t* u = (const bf16_t*)(p.ws + O_PUT) + (size_t)ci * RS + (dv0 + fr) * 64 + mt * 16 + 4 * fq;
        B.Uf[0] = *(const u32x2*)u; B.Uf[1] = *(const u32x2*)(u + 16 * 64);
    }
}
DI void scan_reload_k(const P& p, ScanOps& B, int ci, int w, int fr, int fq) {
    const bf16_t* k = (const bf16_t*)(p.ws + O_PKDT) + (size_t)ci * RS + (w * 16 + fr) * 64 + 8 * fq;
    B.KDf[0] = *(const bf16x8*)k; B.KDf[1] = *(const bf16x8*)(k + 32);
    B.gl = ((const float*)(p.ws + O_GL))[ci];
}
DI void scan_step(const P& p, ScanOps& B, int ci_next, f32x4& s0, f32x4& s1, bf16_t* ST, bf16_t* VT, float* __restrict__ op, int role, int mt, int w, int fr, int fq, int dv0) {
    f32x4 a0 = {0.f, 0.f, 0.f, 0.f}, a1 = {0.f, 0.f, 0.f, 0.f};
#pragma unroll
    for (int ks = 0; ks < 4; ++ks) {
        const bf16x8 b0 = *(const bf16x8*)(ST + fr * 136 + ks * 32 + 8 * fq), b1 = *(const bf16x8*)(ST + (16 + fr) * 136 + ks * 32 + 8 * fq);
        a0 = MFMA16(B.A4[ks], b0, a0); a1 = MFMA16(B.A4[ks], b1, a1);
    }
    scan_reload_a(p, B, ci_next, role, mt, fr, fq);
    if (role == 0) {
        u32x2 w0, w1;
        w0.x = pk2(lo_f(B.Uf[0].x) - a0[0], hi_f(B.Uf[0].x) - a0[1]); w0.y = pk2(lo_f(B.Uf[0].y) - a0[2], hi_f(B.Uf[0].y) - a0[3]);
        w1.x = pk2(lo_f(B.Uf[1].x) - a1[0], hi_f(B.Uf[1].x) - a1[1]); w1.y = pk2(lo_f(B.Uf[1].y) - a1[2], hi_f(B.Uf[1].y) - a1[3]);
        *(u32x2*)(VT + fr * 72 + mt * 16 + 4 * fq) = w0; *(u32x2*)(VT + (16 + fr) * 72 + mt * 16 + 4 * fq) = w1;
        scan_reload_x(p, B, ci_next, 0, mt, fr, fq, dv0);
    }
    lds_barrier();
    const bf16x8 v00 = *(const bf16x8*)(VT + fr * 72 + 8 * fq), v01 = *(const bf16x8*)(VT + fr * 72 + 32 + 8 * fq);
    const bf16x8 v10 = *(const bf16x8*)(VT + (16 + fr) * 72 + 8 * fq), v11 = *(const bf16x8*)(VT + (16 + fr) * 72 + 32 + 8 * fq);
    if (role == 1) {
        a0 = MFMA16(B.QKf[0], v00, a0); a0 = MFMA16(B.QKf[1], v01, a0);
        a1 = MFMA16(B.QKf[0], v10, a1); a1 = MFMA16(B.QKf[1], v11, a1);
        scan_reload_x(p, B, ci_next, 1, mt, fr, fq, dv0);
#pragma unroll
        for (int jj = 0; jj < 4; ++jj) { op[(size_t)jj * 512] = a0[jj]; op[(size_t)jj * 512 + 16] = a1[jj]; }
    }
    s0 = s0 * B.gl; s1 = s1 * B.gl;
    s0 = MFMA16(B.KDf[0], v00, s0); s0 = MFMA16(B.KDf[1], v01, s0);
    s1 = MFMA16(B.KDf[0], v10, s1); s1 = MFMA16(B.KDf[1], v11, s1);
    scan_reload_k(p, B, ci_next, w, fr, fq);
    { u32x2 wv; wv.x = pk2(s0[0], s0[1]); wv.y = pk2(s0[2], s0[3]); *(u32x2*)(ST + fr * 136 + w * 16 + 4 * fq) = wv; }
    { u32x2 wv; wv.x = pk2(s1[0], s1[1]); wv.y = pk2(s1[2], s1[3]); *(u32x2*)(ST + (16 + fr) * 136 + w * 16 + 4 * fq) = wv; }
    lds_barrier();
}
DI void ph_dn_scan(const P& p, unsigned char* lds_, float* __restrict__ OB) {
    bf16_t* ST = (bf16_t*)lds_;
    bf16_t* VT = ST + 32 * 136;
    const int tid = tidx(), lane = tid & 63, w = __builtin_amdgcn_readfirstlane(tid >> 6), fr = lane & 15, fq = lane >> 4, mt = w >> 1, role = w & 1;
    const int vb = (gridDim.x >= 128) ? (int)(blockIdx.x & 7) * 16 + (int)(blockIdx.x >> 3) : (int)blockIdx.x;
    for (int chain = vb; chain < 128; chain += gridDim.x) {
        const int bh = chain >> 2, dv0 = (chain & 3) * 32, b = bh >> 2, h = bh & 3, c0 = bh * 64;
        f32x4 s0 = {0.f, 0.f, 0.f, 0.f}, s1 = {0.f, 0.f, 0.f, 0.f};
        *(u32x2*)(ST + fr * 136 + w * 16 + 4 * fq) = (u32x2){0u, 0u}; *(u32x2*)(ST + (16 + fr) * 136 + w * 16 + 4 * fq) = (u32x2){0u, 0u};
        float* op = OB + ((size_t)b * S_ + mt * 16 + 4 * fq) * 512 + h * 128 + dv0 + fr;
        ScanOps A, Bf, C;
        scan_reload_a(p, A, c0, role, mt, fr, fq); scan_reload_x(p, A, c0, role, mt, fr, fq, dv0); scan_reload_k(p, A, c0, w, fr, fq);
        scan_reload_a(p, Bf, c0 + 1, role, mt, fr, fq); scan_reload_x(p, Bf, c0 + 1, role, mt, fr, fq, dv0); scan_reload_k(p, Bf, c0 + 1, w, fr, fq);
        scan_reload_a(p, C, c0 + 2, role, mt, fr, fq); scan_reload_x(p, C, c0 + 2, role, mt, fr, fq, dv0); scan_reload_k(p, C, c0 + 2, w, fr, fq);
        lds_barrier();
        for (int n = 0; n < 63; n += 3) {
            scan_step(p, A, c0 + (n + 3 < 64 ? n + 3 : 63), s0, s1, ST, VT, op + (size_t)n * 64 * 512, role, mt, w, fr, fq, dv0);
            scan_step(p, Bf, c0 + (n + 4 < 64 ? n + 4 : 63), s0, s1, ST, VT, op + (size_t)(n + 1) * 64 * 512, role, mt, w, fr, fq, dv0);
            scan_step(p, C, c0 + (n + 5 < 64 ? n + 5 : 63), s0, s1, ST, VT, op + (size_t)(n + 2) * 64 * 512, role, mt, w, fr, fq, dv0);
        }
        scan_step(p, A, c0 + 63, s0, s1, ST, VT, op + (size_t)63 * 64 * 512, role, mt, w, fr, fq, dv0);
    }
}

struct AttnRegs { u32x4 kr[4], vr[4]; bf16x8 qf[2]; };
DI void attn_decode(int it, int& g, int& b, int& h, int& r, int& l0, int& d) {
    g = it >> 10; const int rem = it & 1023; b = rem >> 7; h = (rem >> 5) & 3; const int x = rem & 31;
    d = g == 0 ? 1 : (g == 1 ? 4 : 16); const int sh = g * 2; r = x & (d - 1); l0 = (x >> sh) * 128;
}
DI void attn_load(const bf16_t* __restrict__ QKV, int it, int tid, AttnRegs& R) {
    int g, b, h, r, l0, d; attn_decode(it, g, b, h, r, l0, d);
    const int lane = tid & 63, w = tid >> 6, fr = lane & 15, fq = lane >> 4;
#pragma unroll
    for (int i = 0; i < 4; ++i) {
        const int c = tid + 512 * i, key = c >> 3, part = c & 7, sl = l0 - 128 + key;
        if (sl >= 0) { const bf16_t* kp = QKV + ((size_t)b * S_ + (size_t)sl * d + r) * 2304 + 768 + g * 256 + h * 64 + part * 8;
            R.kr[i] = *(const u32x4*)kp; R.vr[i] = *(const u32x4*)(kp + 768); }
        else { R.kr[i] = (u32x4){0u, 0u, 0u, 0u}; R.vr[i] = (u32x4){0u, 0u, 0u, 0u}; }
    }
    const bf16_t* qp = QKV + ((size_t)b * S_ + (size_t)(l0 + 16 * w + fr) * d + r) * 2304 + g * 256 + h * 64 + 8 * fq;
    R.qf[0] = *(const bf16x8*)qp; R.qf[1] = *(const bf16x8*)(qp + 32);
}
DI void ph_attn(const P& p, unsigned char* lds_) {
    bf16_t* Ks = (bf16_t*)lds_;
    bf16_t* VT = Ks + 256 * 72;
    const bf16_t* QKV = (const bf16_t*)(p.ws + O_QKV); bf16_t* OG = (bf16_t*)((unsigned char*)p.out + 64 * MiB); float* LSE = (float*)((unsigned char*)p.out + 112 * MiB);
    AttnRegs R;
    const bool xmap = gridDim.x == 256;
    const int xb = blockIdx.x & 7, xr = blockIdx.x >> 3;
#define ATTN_ITEM(k) (xmap ? ((((xr + 32 * (k)) >> 7) << 10) | (xb << 7) | ((xr + 32 * (k)) & 127)) : (int)blockIdx.x + (k) * (int)gridDim.x)
    const int nit = xmap ? 12 : (3072 - (int)blockIdx.x + (int)gridDim.x - 1) / (int)gridDim.x;
    if (nit > 0) attn_load(QKV, ATTN_ITEM(0), tidx(), R);
    for (int k = 0; k < nit; ++k) { const int it = ATTN_ITEM(k);
        const int tid = tidx(), lane = tid & 63, w = __builtin_amdgcn_readfirstlane(tid >> 6), fr = lane & 15, fq = lane >> 4;
        int g, b, h, r, l0, d; attn_decode(it, g, b, h, r, l0, d);
#pragma unroll
        for (int i = 0; i < 4; ++i) {
            const int c = tid + 512 * i, key = c >> 3, part = c & 7;
            *(u32x4*)(Ks + key * 72 + part * 8) = R.kr[i];
            const unsigned vv[4] = {R.vr[i].x, R.vr[i].y, R.vr[i].z, R.vr[i].w};
#pragma unroll
            for (int e = 0; e < 4; ++e) { VT[(part * 8 + 2 * e) * 264 + key] = (bf16_t)(vv[e] & 0xffffu); VT[(part * 8 + 2 * e + 1) * 264 + key] = (bf16_t)(vv[e] >> 16); }
        }
        const bf16x8 qf0 = R.qf[0], qf1 = R.qf[1];
        lds_barrier();
        if (k + 1 < nit) attn_load(QKV, ATTN_ITEM(k + 1), tid, R);
        const int qt = w, qi = 16 * qt + fr;
        f32x4 st[9];
#pragma unroll
        for (int jt = 0; jt < 9; ++jt) {
            const bf16_t* kp = Ks + (16 * (qt + jt) + fr) * 72 + 8 * fq;
            f32x4 a = {0.f, 0.f, 0.f, 0.f};
            a = MFMA16(*(const bf16x8*)kp, qf0, a);
            a = MFMA16(*(const bf16x8*)(kp + 32), qf1, a);
            st[jt] = a;
        }
        float m = -1e30f;
#pragma unroll
        for (int jt = 0; jt < 9; ++jt)
#pragma unroll
            for (int jj = 0; jj < 4; ++jj) {
                const int j = 16 * (qt + jt) + 4 * fq + jj;
                const bool valid = (j >= qi) && (j <= 128 + qi) && (l0 - 128 + j >= 0);
                const float s = valid ? st[jt][jj] * (0.125f * 1.44269504089f) : -1e30f;
                st[jt][jj] = s; m = fmaxf(m, s);
            }
        m = fmaxf(m, __shfl_xor(m, 16)); m = fmaxf(m, __shfl_xor(m, 32));
        float den = 0.f;
#pragma unroll
        for (int jt = 0; jt < 9; ++jt)
#pragma unroll
            for (int jj = 0; jj < 4; ++jj) { const float e = __builtin_amdgcn_exp2f(st[jt][jj] - m); st[jt][jj] = e; den += e; }
        den += __shfl_xor(den, 16); den += __shfl_xor(den, 32);
        f32x4 o[4];
#pragma unroll
        for (int dt = 0; dt < 4; ++dt) o[dt] = (f32x4){0.f, 0.f, 0.f, 0.f};
#pragma unroll
        for (int a = 0; a < 5; ++a) {
            u32x4 pw; pw.x = pk2(st[2 * a][0], st[2 * a][1]); pw.y = pk2(st[2 * a][2], st[2 * a][3]);
            if (a < 4) { pw.z = pk2(st[2 * a + 1][0], st[2 * a + 1][1]); pw.w = pk2(st[2 * a + 1][2], st[2 * a + 1][3]); } else { pw.z = 0u; pw.w = 0u; }
            const bf16x8 pf = __builtin_bit_cast(bf16x8, pw);
            const int kA = 16 * (qt + 2 * a) + 4 * fq, kB = a < 4 ? kA + 16 : kA;
#pragma unroll
            for (int dt = 0; dt < 4; ++dt) {
                const bf16_t* vp = VT + (dt * 16 + fr) * 264;
                const u32x2 va = *(const u32x2*)(vp + kA), vb = *(const u32x2*)(vp + kB);
                const bf16x8 vf = __builtin_bit_cast(bf16x8, ((u32x4){va.x, va.y, vb.x, vb.y}));
                o[dt] = MFMA16(vf, pf, o[dt]);
            }
        }
        const size_t row = (size_t)b * S_ + (size_t)(l0 + qi) * d + r;
        const float inv = 1.f / den;
        bf16_t* op = OG + ((size_t)g * T_ + row) * 256 + h * 64 + 4 * fq;
#pragma unroll
        for (int dt = 0; dt < 4; ++dt) { u32x2 wv; wv.x = pk2(o[dt][0] * inv, o[dt][1] * inv); wv.y = pk2(o[dt][2] * inv, o[dt][3] * inv); *(u32x2*)(op + dt * 16) = wv; }
        if (fq == 0) LSE[((size_t)g * T_ + row) * 4 + h] = (m + log2f(den)) * 0.69314718056f;
        lds_barrier();
    }
}

DI void ph_merge_oa(const P& p, int bid, int nblk) {
    const int lane = tidx() & 63, wave = tidx() >> 6;
    const bf16_t* OG = (const bf16_t*)((unsigned char*)p.out + 64 * MiB); const float* LSE = (const float*)((unsigned char*)p.out + 112 * MiB);
    bf16_t* OA = (bf16_t*)(p.ws + O_OA);
    const int hh = lane >> 4;
    for (int t = bid * 8 + wave; t < T_; t += nblk * 8) {
        float ls[3], mx = -1e30f;
#pragma unroll
        for (int g = 0; g < 3; ++g) { ls[g] = LSE[((size_t)g * T_ + t) * 4 + hh]; mx = fmaxf(mx, ls[g]); }
        float e[3], se = 0.f;
#pragma unroll
        for (int g = 0; g < 3; ++g) { e[g] = expf(ls[g] - mx); se += e[g]; }
        float a0 = 0.f, a1 = 0.f, a2 = 0.f, a3 = 0.f;
#pragma unroll
        for (int g = 0; g < 3; ++g) { const u32x2 v = *(const u32x2*)(OG + ((size_t)g * T_ + t) * 256 + 4 * lane); const float al = e[g] / se;
            a0 += al * lo_f(v.x); a1 += al * hi_f(v.x); a2 += al * lo_f(v.y); a3 += al * hi_f(v.y); }
        { u32x2 w; w.x = pk2(a0, a1); w.y = pk2(a2, a3); *(u32x2*)(OA + (size_t)t * 256 + 4 * lane) = w; }
    }
}
DI void ph_merge(const P& p, int l, const float* __restrict__ OB) {
    const int lane = tidx() & 63, wave = tidx() >> 6;
    const bf16_t* DZ = (const bf16_t*)(p.ws + O_DZ);
    bf16_t* OBN = (bf16_t*)(p.ws + O_OBN);
    const float* onw = p.dn_onorm_w + l * 128;
    for (int t = blockIdx.x * 8 + wave; t < T_; t += gridDim.x * 8) {
        const f32x4* ob = (const f32x4*)(OB + (size_t)t * 512 + 8 * lane);
        const f32x4 b0 = ob[0], b1 = ob[1];
        float ss = b0.x * b0.x + b0.y * b0.y + b0.z * b0.z + b0.w * b0.w + b1.x * b1.x + b1.y * b1.y + b1.z * b1.z + b1.w * b1.w;
#pragma unroll
        for (int o = 1; o < 16; o <<= 1) ss += __shfl_xor(ss, o);
        const float r = 1.f / sqrtf(ss * (1.f / 128.f) + 1e-6f);
        float z[8]; unpack8(*(const u32x4*)(DZ + (size_t)t * 512 + 8 * lane), z);
        const f32x4 w0 = *(const f32x4*)(onw + ((8 * lane) & 127)), w1 = *(const f32x4*)(onw + ((8 * lane) & 127) + 4);
        f32x4 y0, y1;
#pragma unroll
        for (int i = 0; i < 4; ++i) { y0[i] = b0[i] * r * w0[i] * fsilu(z[i]); y1[i] = b1[i] * r * w1[i] * fsilu(z[4 + i]); }
        *(u32x4*)(OBN + (size_t)t * 512 + 8 * lane) = pack8(y0, y1);
    }
}

DI void ph_convglu(const P& p, int l, int half) {
    const bf16_t* U = (const bf16_t*)(p.ws + O_UPH); bf16_t* ACT = (bf16_t*)(p.ws + O_ACT);
    const float* cw = p.ffn_conv_w + (size_t)l * 3 * NUP; const float* cb = p.ffn_conv_b + (size_t)l * NUP;
    const int HT = T_ / 2, NC8 = DFF / 8, RB = 16;
    for (int it = blockIdx.x * NT + tidx(); it < (HT / RB) * NC8; it += gridDim.x * NT) {
        const int rb = it / NC8, c = (it % NC8) * 8, row0 = rb * RB;
        float wg[3][8], wv[3][8], bg[8], bv[8];
#pragma unroll
        for (int j = 0; j < 3; ++j) { const f32x4 a = *(const f32x4*)(cw + j * NUP + c), b = *(const f32x4*)(cw + j * NUP + c + 4), cc = *(const f32x4*)(cw + j * NUP + DFF + c), d = *(const f32x4*)(cw + j * NUP + DFF + c + 4);
#pragma unroll
            for (int e = 0; e < 4; ++e) { wg[j][e] = a[e]; wg[j][4 + e] = b[e]; wv[j][e] = cc[e]; wv[j][4 + e] = d[e]; } }
        { const f32x4 a = *(const f32x4*)(cb + c), b = *(const f32x4*)(cb + c + 4), cc = *(const f32x4*)(cb + DFF + c), d = *(const f32x4*)(cb + DFF + c + 4);
#pragma unroll
          for (int e = 0; e < 4; ++e) { bg[e] = a[e]; bg[4 + e] = b[e]; bv[e] = cc[e]; bv[4 + e] = d[e]; } }
        u32x4 g2 = {0u, 0u, 0u, 0u}, g1 = g2, v2 = g2, v1 = g2;
        if ((row0 % S_) != 0) { const bf16_t* up = U + (size_t)(row0 - 2) * NUP + c; g2 = *(const u32x4*)up; v2 = *(const u32x4*)(up + DFF); g1 = *(const u32x4*)(up + NUP); v1 = *(const u32x4*)(up + NUP + DFF); }
#pragma unroll 4
        for (int i = 0; i < RB; ++i) {
            const bf16_t* up = U + (size_t)(row0 + i) * NUP + c;
            const u32x4 g0 = *(const u32x4*)up, v0 = *(const u32x4*)(up + DFF);
            float a2[8], a1[8], a0[8], b2[8], b1[8], b0[8];
            unpack8(g2, a2); unpack8(g1, a1); unpack8(g0, a0); unpack8(v2, b2); unpack8(v1, b1); unpack8(v0, b0);
            float y[8];
#pragma unroll
            for (int e = 0; e < 8; ++e) {
                const float gs = bg[e] + wg[0][e] * a2[e] + wg[1][e] * a1[e] + wg[2][e] * a0[e];
                const float vs = bv[e] + wv[0][e] * b2[e] + wv[1][e] * b1[e] + wv[2][e] * b0[e];
                y[e] = fsilu(gs) * vs;
            }
            *(u32x4*)(ACT + (size_t)(half * HT + row0 + i) * DFF + c) = pack8((f32x4){y[0], y[1], y[2], y[3]}, (f32x4){y[4], y[5], y[6], y[7]});
            g2 = g1; g1 = g0; v2 = v1; v1 = v0;
        }
    }
}


constexpr size_t O_HEAD = O_ACT + 176 * MiB, O_TAIL = O_HEAD + 22 * MiB;
template <int CTRL> DI float dppf(float x) { return __builtin_bit_cast(float, __builtin_amdgcn_update_dpp(0, __builtin_bit_cast(int, x), CTRL, 0xf, 0xf, true)); }
struct EpiConvGlu {
    static constexpr bool PERM = true, AFTER_DRAIN = false;
    bf16_t* ACT; float* HEAD; float* TAIL; const float* cw; const float* cb;
    DI void operator()(const pg8::f32x4 (&acc)[2][2][4][2], const pg8::Unit& u, int wr, int wc, int fr, int fq) const {
        const int chb = 128 * u.pn + 32 * wc + 8 * fq;
#pragma unroll
        for (int n = 0; n < 2; ++n) {
            const unsigned ch = (unsigned)(chb + 4 * n), cq = ch >> 2;
            const f32x4* __restrict__ W0 = (const f32x4*)cw; const f32x4* __restrict__ W1 = (const f32x4*)(cw + NUP); const f32x4* __restrict__ W2 = (const f32x4*)(cw + 2 * NUP); const f32x4* __restrict__ WB = (const f32x4*)cb;
            const f32x4 g0 = W0[cq], g1 = W1[cq], g2 = W2[cq], gb = WB[cq];
            const f32x4 v0 = W0[cq + DFF / 4], v1 = W1[cq + DFF / 4], v2 = W2[cq + DFF / 4], vb = WB[cq + DFF / 4];
            asm volatile("" ::: "memory"); __builtin_amdgcn_sched_barrier(0);
#pragma unroll
            for (int ai = 0; ai < 2; ++ai) {
                const int grp = 4 * u.pm + 2 * ai + wr;
                f32x4 act[4], hg, hv; float chain = 0.f;
#pragma unroll
                for (int e = 0; e < 4; ++e) {
                    float pg15 = 0.f, pg14 = 0.f, pv15 = 0.f, pv14 = 0.f;
#pragma unroll
                    for (int m = 0; m < 4; ++m) {
                        float xg = acc[ai][0][m][n][e], xv = acc[ai][1][m][n][e];
                        asm volatile("" : "+v"(xg), "+v"(xv) : "v"(chain));
                        const float g_1 = dppf<0x111>(xg) + pg15, g_2 = dppf<0x112>(xg) + pg14;
                        const float v_1 = dppf<0x111>(xv) + pv15, v_2 = dppf<0x112>(xv) + pv14;
                        const float yg = gb[e] + g0[e] * g_2 + g1[e] * g_1 + g2[e] * xg;
                        const float yv = vb[e] + v0[e] * v_2 + v1[e] * v_1 + v2[e] * xv;
                        if (m == 0) { hg[e] = yg; hv[e] = yv; }
                        act[m][e] = fsilu(yg) * yv; chain = act[m][e];
                        if (m < 3) { pg15 = dppf<0x10F>(xg); pg14 = dppf<0x10E>(xg); pv15 = dppf<0x10F>(xv); pv14 = dppf<0x10E>(xv); }
                    }
                    __builtin_amdgcn_sched_barrier(0);
                }
                if (fr < 2) { const unsigned ho = ((unsigned)(grp * 2 + fr) * NUP + ch) * 4u; *(f32x4*)((char*)HEAD + ho) = hg; *(f32x4*)((char*)HEAD + ho + DFF * 4u) = hv; }
#pragma unroll
                for (int m = 0; m < 4; ++m) {
                    if (!(m == 0 && fr < 2)) {
                        u32x2 wv; wv.x = pk2(act[m][0], act[m][1]); wv.y = pk2(act[m][2], act[m][3]);
                        const unsigned ao = ((unsigned)(grp * 64 + 16 * m + fr) * DFF + ch) * 2u;
                        *(u32x2*)((char*)ACT + ao) = wv;
                    }
                }
                if (fr >= 14) { const unsigned to = ((unsigned)(grp * 2 + (fr - 14)) * NUP + ch) * 4u; *(f32x4*)((char*)TAIL + to) = acc[ai][0][3][n]; *(f32x4*)((char*)TAIL + to + DFF * 4u) = acc[ai][1][3][n]; }
                asm volatile("" ::: "memory"); __builtin_amdgcn_sched_barrier(0);
            }
        }
    }
};
DI void ph_ffn_fix(const P& p, int l) {
    bf16_t* ACT = (bf16_t*)(p.ws + O_ACT); const float* HEAD = (const float*)(p.ws + O_HEAD); const float* TAIL = (const float*)(p.ws + O_TAIL);
    const float* cw = p.ffn_conv_w + (size_t)l * 3 * NUP;
    for (int it = blockIdx.x * NT + tidx(); it < 512 * (DFF / 4); it += gridDim.x * NT) {
        const int g = it / (DFF / 4), ch = (it % (DFF / 4)) * 4;
        const bool first = (g & 63) == 0;
        const float* hp = HEAD + (size_t)g * 2 * NUP + ch;
        f32x4 yg0 = *(const f32x4*)hp, yv0 = *(const f32x4*)(hp + DFF), yg1 = *(const f32x4*)(hp + NUP), yv1 = *(const f32x4*)(hp + NUP + DFF);
        if (!first) {
            const float* tp = TAIL + (size_t)(g - 1) * 2 * NUP + ch;
            const f32x4 tg0 = *(const f32x4*)tp, tv0 = *(const f32x4*)(tp + DFF), tg1 = *(const f32x4*)(tp + NUP), tv1 = *(const f32x4*)(tp + NUP + DFF);
            const f32x4 w0g = *(const f32x4*)(cw + ch), w1g = *(const f32x4*)(cw + NUP + ch), w0v = *(const f32x4*)(cw + DFF + ch), w1v = *(const f32x4*)(cw + NUP + DFF + ch);
            yg0 = yg0 + w1g * tg1 + w0g * tg0; yv0 = yv0 + w1v * tv1 + w0v * tv0;
            yg1 = yg1 + w0g * tg1; yv1 = yv1 + w0v * tv1;
        }
        u32x2 a, b;
        a.x = pk2(fsilu(yg0[0]) * yv0[0], fsilu(yg0[1]) * yv0[1]); a.y = pk2(fsilu(yg0[2]) * yv0[2], fsilu(yg0[3]) * yv0[3]);
        b.x = pk2(fsilu(yg1[0]) * yv1[0], fsilu(yg1[1]) * yv1[1]); b.y = pk2(fsilu(yg1[2]) * yv1[2], fsilu(yg1[3]) * yv1[3]);
        *(u32x2*)(ACT + (size_t)g * 64 * DFF + ch) = a; *(u32x2*)(ACT + ((size_t)g * 64 + 1) * DFF + ch) = b;
    }
}
template <class E> DI void gemm_fast_epi(unsigned char* lds, const bf16_t* A, const bf16_t* WT, int M, int N, int K, const E& e) {
    asm volatile("" : "+s"(K));
    pg8::Gemm g{A, WT, M, N, K}; pg8::StaticOrder S; S.init(M, N, (int)gridDim.x, (int)blockIdx.x);
    pg8::gemm_phase((PG8_LAS unsigned char*)lds, g, S, e);
}

constexpr size_t O_RBF = O_QKV;
DI void ph_final(const P& p) {
    const int lane = tidx() & 63, wave = tidx() >> 6;
    const bf16_t* RB = (const bf16_t*)(p.ws + O_RBF);
    for (int row = blockIdx.x * 8 + wave; row < T_; row += gridDim.x * 8) {
        const u32x2* xb = (const u32x2*)(RB + (size_t)row * DM) + lane;
        f32x4* xr = (f32x4*)(p.out + (size_t)row * DM) + lane;
        f32x4 v[4]; float ss = 0.f;
#pragma unroll
        for (int j = 0; j < 4; ++j) { const u32x2 q = xb[64 * j]; v[j] = (f32x4){lo_f(q.x), hi_f(q.x), lo_f(q.y), hi_f(q.y)}; ss += v[j].x * v[j].x + v[j].y * v[j].y + v[j].z * v[j].z + v[j].w * v[j].w; }
        ss = wave_sum(ss);
        const float r = 1.f / sqrtf(ss * (1.f / DM) + 1e-6f);
#pragma unroll
        for (int j = 0; j < 4; ++j) { const f32x4 ww = ((const f32x4*)p.final_norm_w)[lane + 64 * j]; xr[64 * j] = v[j] * r * ww; }
    }
}

#define XB_TMO      128
#define XB_XCNT(j)  (256  + 64 * (j))
#define XB_XSUB(j)  (1280 + 64 * (j))
#define XB_XGEN(j)  (2304 + 64 * (j))
#define XB_TOP      3328
#define XB_TOPGEN   3392
#define XCD_BAR_WORDS 3456
#define XB_SPIN_CAP (1u << 18)
#define LAS __attribute__((address_space(3)))

__device__ __forceinline__ unsigned xb_ld(unsigned* p)              { return __hip_atomic_load(p, __ATOMIC_RELAXED, __HIP_MEMORY_SCOPE_AGENT); }
__device__ __forceinline__ unsigned xb_add(unsigned* p, unsigned v) { return __hip_atomic_fetch_add(p, v, __ATOMIC_RELAXED, __HIP_MEMORY_SCOPE_AGENT); }
__device__ __forceinline__ unsigned xb_xcc_id() { return (unsigned)__builtin_amdgcn_s_getreg((3 << 11) | 20) & 0xFu; }
#define XB_SPIN(cond, bar) do { unsigned _sp = 0; while (cond) { __builtin_amdgcn_s_sleep(1); \
    if ((++_sp & 255u) == 0u) { if (xb_ld(&(bar)[XB_TMO])) break; if (_sp > XB_SPIN_CAP) { atomicAdd(&(bar)[XB_TMO], 1u); break; } } } } while (0)

struct XcdBarrier {
    unsigned* bar; unsigned x;
    volatile LAS unsigned* st;
};

__device__ __forceinline__ XcdBarrier xcd_barrier_post(unsigned* bar, volatile LAS unsigned* st) {
    XcdBarrier b; b.bar = bar; b.x = xb_xcc_id(); b.st = st;
    if (threadIdx.x == 0) (void)xb_add(&bar[XB_XCNT(b.x)], 1u);
    return b;
}
__device__ __forceinline__ void xcd_barrier_complete(unsigned* bar, unsigned x, unsigned& nloc, unsigned& nx) {
    const unsigned G = gridDim.x * gridDim.y * gridDim.z;
    unsigned sum, cnt, mine, sp = 0u;
    for (;;) {
        sum = 0u; cnt = 0u; mine = 0u;
#pragma unroll
        for (unsigned j = 0; j < 16; ++j) { const unsigned c = xb_ld(&bar[XB_XCNT(j)]); sum += c; cnt += (c > 0u) ? 1u : 0u; mine = (j == x) ? c : mine; }
        if (sum == G) break;
        __builtin_amdgcn_s_sleep(1);
        if ((++sp & 255u) == 0u) { if (xb_ld(&bar[XB_TMO])) break; if (sp > XB_SPIN_CAP) { atomicAdd(&bar[XB_TMO], 1u); break; } }
    }
    nloc = mine > 0u ? mine : 1u; nx = cnt > 0u ? cnt : 1u;
}

__device__ __forceinline__ void xcd_barrier(const XcdBarrier& b) {
    asm volatile("s_waitcnt vmcnt(0)" ::: "memory");
    __syncthreads();
    if (threadIdx.x == 0) {
        unsigned* bar = b.bar;
        __builtin_amdgcn_s_waitcnt(0);
        unsigned nloc = b.st[0], nx = b.st[1];
        if (nloc == 0u) { xcd_barrier_complete(bar, b.x, nloc, nx); b.st[0] = nloc; b.st[1] = nx; }
        const unsigned old = xb_add(&bar[XB_XSUB(b.x)], 1u);
        const unsigned gen = old / nloc;
        if (old + 1u == (gen + 1u) * nloc) {
            __builtin_amdgcn_fence(__ATOMIC_RELEASE, "agent");
            asm volatile("s_waitcnt vmcnt(0)" ::: "memory");
            const unsigned og = xb_add(&bar[XB_TOP], 1u);
            const unsigned tg = og / nx;
            if (og + 1u == (tg + 1u) * nx) xb_add(&bar[XB_TOPGEN], 1u);
            else XB_SPIN(xb_ld(&bar[XB_TOPGEN]) == tg, bar);
            __builtin_amdgcn_fence(__ATOMIC_ACQUIRE, "agent");
            xb_add(&bar[XB_XGEN(b.x)], 1u);
            asm volatile("s_waitcnt vmcnt(0)" ::: "memory");
        } else {
            XB_SPIN(xb_ld(&bar[XB_XGEN(b.x)]) == gen, bar);
            __builtin_amdgcn_fence(__ATOMIC_ACQUIRE, "agent");
            asm volatile("s_waitcnt vmcnt(0)" ::: "memory");
        }
    }
    __syncthreads();
}

template <class F> DI void gemm_fast_sub(unsigned char* lds, const bf16_t* A, const bf16_t* WT, int M, int N, int K, const F& f, int G, int c) {
    asm volatile("" : "+s"(K));
    pg8::Gemm g{A, WT, M, N, K}; pg8::StaticOrder S; S.init(M, N, G, c);
    EpiAdapt<F> E{f};
    pg8::gemm_phase((PG8_LAS unsigned char*)lds, g, S, E);
}
#ifndef XSYNC
#define XSYNC 0
#endif
#ifndef DUPMASK
#define DUPMASK 0
#endif
#ifndef FAST_DN
#define FAST_DN 1
#endif
#ifndef FAST_ATTN
#define FAST_ATTN 1
#endif
constexpr int STEPS_PER_LAYER = 12, NSTEPS = 2 * STEPS_PER_LAYER + 1;
DI void run_step(const P& p, int step, unsigned char* lds) {
    bf16_t* WB = (bf16_t*)(p.ws + O_W);
    if (step == NSTEPS - 1) { ph_final(p); return; }
    const int l = step / STEPS_PER_LAYER, s = step % STEPS_PER_LAYER;
    bf16_t* RB = (bf16_t*)p.out;
    float* OBp = (float*)(p.ws + (FAST_DN ? O_DQKV : O_OBN_NAIVE));
    switch (s) {
    case 0: ph_convert(p, l, lds); if (l == 0) ph_rmsnorm<false>(p, p.x, p.norm1_w + l * DM, l, lds); else ph_rmsnorm<true>(p, RB, p.norm1_w + l * DM, l, lds); break;
    case 1: { EpiIn e{(bf16_t*)(p.ws + O_QKV), (bf16_t*)(p.ws + O_DQKV), (bf16_t*)(p.ws + O_DZ), (bf16_t*)(p.ws + O_SG), 0};
              GEMM((const bf16_t*)(p.ws + O_XN), WB + W_IN, T_, gridDim.x == 256 ? NIN - 256 : NIN, 1024, e); } break;
#if FAST_ATTN
    case 2: ph_attn(p, lds); break;
#else
    case 2: ph_attn_naive(p); break;
#endif
#if FAST_DN
    case 3: ph_dn_prep(p, l, lds); break;
    case 4: if (gridDim.x > 128) { if (blockIdx.x < 128) ph_dn_scan(p, lds, OBp);
                else { ph_merge_oa(p, (int)blockIdx.x - 128, (int)gridDim.x - 128);
                    if (gridDim.x == 256) { EpiIn e{(bf16_t*)(p.ws + O_QKV), (bf16_t*)(p.ws + O_DQKV), (bf16_t*)(p.ws + O_DZ), (bf16_t*)(p.ws + O_SG), NIN - 256};
                        gemm_fast_sub(lds, (const bf16_t*)(p.ws + O_XN), WB + W_IN + (size_t)(NIN - 256) * 1024, T_, 256, 1024, e, 128, (int)blockIdx.x - 128); } } }
            else { ph_dn_scan(p, lds, OBp); ph_merge_oa(p, (int)blockIdx.x, (int)gridDim.x); } break;
#else
    case 3: ph_dn_naive(p, l, lds, OBp); break;
    case 4: break;
#endif
    case 5: ph_merge(p, l, OBp); break;
    case 6: { EpiGate<0> e0{(bf16_t*)(p.ws + O_Y), (const bf16_t*)(p.ws + O_SG), 0};
              GEMM((const bf16_t*)(p.ws + O_OA), WB + W_PA, T_, 1024, 256, e0);
              EpiGate<1> e1{(bf16_t*)(p.ws + O_Y), (const bf16_t*)(p.ws + O_SG), 1024};
              GEMM((const bf16_t*)(p.ws + O_OBN), WB + W_PB, T_, 1024, 512, e1); } break;
    case 7: if (l == 0) { EpiResB<true> e{p.x, RB}; GEMM((const bf16_t*)(p.ws + O_Y), WB + W_O, T_, 1024, 1024, e); }
            else { EpiResB<false> e{RB, RB}; GEMM((const bf16_t*)(p.ws + O_Y), WB + W_O, T_, 1024, 1024, e); } break;
    case 8: ph_rmsnorm<true>(p, RB, p.norm2_w + l * DM, -1, lds); break;
    case 9: { EpiConvGlu e{(bf16_t*)(p.ws + O_ACT), (float*)(p.ws + O_HEAD), (float*)(p.ws + O_TAIL), p.ffn_conv_w + (size_t)l * 3 * NUP, p.ffn_conv_b + (size_t)l * NUP};
              gemm_fast_epi(lds, (const bf16_t*)(p.ws + O_XN), WB + W_UP, T_, NUP, 1024, e); } break;
    case 10: ph_ffn_fix(p, l); break;
    case 11: { EpiResB<false> e{RB, l == 1 ? (bf16_t*)(p.ws + O_RBF) : RB}; GEMM((const bf16_t*)(p.ws + O_ACT), WB + W_DN, T_, 1024, DFF, e); } break;
    }
}

__global__ void __launch_bounds__(NT, 2) k_step(P p, int step) {
    extern __shared__ __attribute__((aligned(16))) unsigned char lds[];
    run_step(p, step, lds);
}
#if MODE_COOP
__global__ void __launch_bounds__(NT, 2) k_mega(P p) {
    extern __shared__ __attribute__((aligned(16))) unsigned char lds[];
    cg::grid_group grid = cg::this_grid();
    volatile LAS unsigned* stw = (volatile LAS unsigned*)((LAS unsigned char*)lds + 131072);
    if (threadIdx.x < 4) stw[threadIdx.x] = 0u;
    __syncthreads();
    const XcdBarrier xbar = xcd_barrier_post((unsigned*)(p.ws + O_BAR), stw);
#pragma unroll 1
    for (int s = 0; s < NSTEPS; ++s) {
        run_step(p, s, lds);
#if DUPMASK
        if (s < NSTEPS - 1 && ((DUPMASK >> (s % STEPS_PER_LAYER)) & 1)) { grid.sync(); run_step(p, s, lds); }
#endif
        if (s + 1 < NSTEPS) { if (p.ws == nullptr) grid.sync(); else xcd_barrier(xbar); }
#if XSYNC
        if (s == 4) { for (int q = 0; q < XSYNC; ++q) grid.sync(); }
#endif
    }
}
#define K_MAIN k_mega
#else
#define K_MAIN k_step
#endif

extern "C" void kernel_launch(void* const* d_in, const int* in_sizes, int n_in, void* d_out, int out_size, void* d_ws, size_t ws_size, hipStream_t stream) {
    static int grid = 0;
    if (grid == 0) {
        if (n_in != 16 || out_size != T_ * DM || ws_size < O_END) { fprintf(stderr, "kernel_launch: unexpected shapes (n_in %d out %d ws %zu)\n", n_in, out_size, ws_size); grid = -1; return; }
        int dev = 0, cus = 0, per_cu = 0;
        (void)hipGetDevice(&dev);
        (void)hipDeviceGetAttribute(&cus, hipDeviceAttributeMultiprocessorCount, dev);
        if (cus <= 0) cus = 256;
        (void)hipFuncSetAttribute((const void*)K_MAIN, hipFuncAttributeMaxDynamicSharedMemorySize, LDS_BYTES);
        (void)hipOccupancyMaxActiveBlocksPerMultiprocessor(&per_cu, (const void*)K_MAIN, NT, LDS_BYTES);
        if (per_cu < 1) per_cu = 1;
        if (per_cu > 1) per_cu = 1;
        grid = cus * per_cu;
        (void)hipGetLastError();
    }
    if (grid < 0) return;
    P p{};
    const float** pp = (const float**)&p;
    for (int i = 0; i < 16; ++i) pp[i] = (const float*)d_in[i];
    p.out = (float*)d_out; p.ws = (unsigned char*)d_ws;
#if MODE_COOP
    (void)hipMemsetAsync((unsigned char*)d_ws + O_BAR, 0, XCD_BAR_WORDS * sizeof(unsigned), stream);
    void* args[] = {&p};
    hipError_t e = hipLaunchCooperativeKernel((const void*)k_mega, dim3(grid), dim3(NT), args, LDS_BYTES, stream);
    if (e != hipSuccess) fprintf(stderr, "cooperative launch failed: %s (grid %d)\n", hipGetErrorString(e), grid);
#else
    for (int s = 0; s < NSTEPS; ++s) hipLaunchKernelGGL(k_step, dim3(grid), dim3(NT), LDS_BYTES, stream, p, s);
#endif
}
```
